# Optimizing an MI355X kernel written in HIP

```python
import jax, jax.numpy as jnp
from jax import lax
import numpy as np

D_MODEL = 1024
BATCH = 8
SEQ = 2048
DEPTH = 4

GRID_W = 64
N_MEM = 256
HEAD_DIM = 64
N_BRANCH = 4
BRANCH_WIDTH = D_MODEL // N_BRANCH
IN_WIDTH = 9 * BRANCH_WIDTH
RET_HEADS = BRANCH_WIDTH // HEAD_DIM
RET_CHUNK = 128
ROPE_THETA = 10000.0
POOL_WINDOWS = (2, 4, 8, 16)
POOL_GROUPS = len(POOL_WINDOWS)
POOL_GROUP_DIM = BRANCH_WIDTH // POOL_GROUPS
NA_HEADS = BRANCH_WIDTH // HEAD_DIM
NA_WIN_ROWS = 8
NA_WIN_COLS = 16
NA_QBLOCK_COLS = 16
NA_KBLOCK_COLS = 2 * NA_QBLOCK_COLS
MEM_HEADS = BRANCH_WIDTH // HEAD_DIM
FF_HIDDEN = -(-8 * D_MODEL // (3 * 256)) * 256
NEG_INF = -1e30
EPS = 1e-6

kernel_name = "hybrid_retention_pool_natten_memory_encoder"


def rms_norm(x, g):
    xf = x.astype(jnp.float32)
    y = xf * lax.rsqrt(jnp.mean(xf * xf, axis=-1, keepdims=True) + EPS)
    return (y * g.astype(jnp.float32)).astype(x.dtype)


def split_heads(t, n_heads):
    b, s, _ = t.shape
    return t.reshape(b, s, n_heads, -1).transpose(0, 2, 1, 3)


def merge_heads(t):
    b, h, s, d = t.shape
    return t.transpose(0, 2, 1, 3).reshape(b, s, h * d)


def rotary(t, pos):
    half = t.shape[-1] // 2
    inv = ROPE_THETA ** (-jnp.arange(half, dtype=jnp.float32) / half)
    ang = pos[:, None] * inv[None, :]
    cos, sin = jnp.cos(ang), jnp.sin(ang)
    tf = t.astype(jnp.float32)
    t1, t2 = tf[..., :half], tf[..., half:]
    return jnp.concatenate([t1 * cos - t2 * sin, t1 * sin + t2 * cos], axis=-1).astype(t.dtype)


def retention_dir(q, k, v, log_gamma, include_diag):
    b, h, s, d = q.shape
    c = RET_CHUNK
    n = s // c
    dt = q.dtype
    qc, kc, vc = (t.reshape(b, h, n, c, d) for t in (q, k, v))
    idx = jnp.arange(c, dtype=jnp.float32)
    diff = idx[:, None] - idx[None, :]
    mask = (diff >= 0) if include_diag else (diff > 0)
    lg = log_gamma.astype(jnp.float32)[:, None]
    d_intra = jnp.where(mask[None], jnp.exp(jnp.where(mask, diff, 0.0)[None] * lg[:, :, None]), 0.0)
    scores = jnp.einsum('bhncd,bhnmd->bhncm', qc, kc) * d_intra[None, :, None].astype(dt)
    intra = jnp.einsum('bhncm,bhnme->bhnce', scores, vc)
    k_decay = jnp.exp((c - 1 - idx)[None, :] * lg).astype(dt)
    kv = jnp.einsum('bhncd,bhnce->nbhde', kc * k_decay[None, :, None, :, None], vc)
    chunk_decay = jnp.exp(c * lg[:, 0]).astype(dt)[None, :, None, None]

    def step(state, kv_n):
        return chunk_decay * state + kv_n, state

    _, states = lax.scan(step, jnp.zeros_like(kv[0]), kv)
    q_decay = jnp.exp((idx + 1)[None, :] * lg).astype(dt)
    cross = jnp.einsum('bhncd,nbhde->bhnce', qc * q_decay[None, :, None, :, None], states)
    return (intra + cross).reshape(b, h, s, d)


def bidirectional_retention(q, k, v, log_gamma_fwd, log_gamma_bwd):
    fwd = retention_dir(q, k, v, log_gamma_fwd, True)
    flip = lambda t: jnp.flip(t, axis=2)
    bwd = flip(retention_dir(flip(q), flip(k), flip(v), log_gamma_bwd, False))
    return fwd + bwd


def multiscale_pool(v, w_group, scale):
    b, s, cw = v.shape
    vg = v.reshape(b, s, POOL_GROUPS, POOL_GROUP_DIM)
    cs = jnp.cumsum(vg.astype(jnp.float32), axis=1)
    cs = jnp.concatenate([jnp.zeros_like(cs[:, :1]), cs], axis=1)
    t = np.arange(s)[:, None]
    half = np.array(POOL_WINDOWS)[None, :] // 2
    lo = np.clip(t - half, 0, s)
    hi = np.clip(t + half, 0, s)
    g_idx = np.arange(POOL_GROUPS)[None, :]
    win_sum = cs[:, hi, g_idx] - cs[:, lo, g_idx]
    count = jnp.asarray((hi - lo)[None, :, :, None], dtype=jnp.float32)
    pooled = (win_sum / count).astype(v.dtype) - vg
    mixed = jnp.einsum('bsgc,gce->bsge', pooled, w_group)
    return mixed.reshape(b, s, cw) * scale


def neighbourhood_attention(q, k, v, rpb):
    b, h, s, d = q.shape
    rows = s // GRID_W
    wr = min(NA_WIN_ROWS, rows)
    n_cb = GRID_W // NA_QBLOCK_COLS
    r = np.arange(rows)
    row_idx = np.clip(r - wr // 2, 0, rows - wr)[:, None] + np.arange(wr)[None, :]
    cb = np.arange(n_cb)
    kcol_idx = np.clip(cb * NA_QBLOCK_COLS - NA_WIN_COLS // 2, 0, GRID_W - NA_KBLOCK_COLS)[:, None] \
        + np.arange(NA_KBLOCK_COLS)[None, :]
    qcol = cb[:, None] * NA_QBLOCK_COLS + np.arange(NA_QBLOCK_COLS)[None, :]
    qwin = np.clip(qcol - NA_WIN_COLS // 2, 0, GRID_W - NA_WIN_COLS)
    col_mask = (kcol_idx[:, None, :] >= qwin[:, :, None]) & (kcol_idx[:, None, :] < qwin[:, :, None] + NA_WIN_COLS)
    row_off = row_idx - r[:, None]
    col_off = np.clip(kcol_idx[:, None, :] - qcol[:, :, None], -(NA_WIN_COLS - 1), NA_WIN_COLS - 1)
    bias = rpb[:, row_off[:, None, None, :, None] + NA_WIN_ROWS - 1,
               col_off[None, :, :, None, :] + NA_WIN_COLS - 1]
    bias = jnp.where(col_mask[None, None, :, :, None, :], bias.astype(jnp.float32), NEG_INF)

    qg = q.reshape(b, h, rows, n_cb, NA_QBLOCK_COLS, d)
    k_grid = k.reshape(b, h, rows, GRID_W, d)
    v_grid = v.reshape(b, h, rows, GRID_W, d)
    ri = row_idx[:, None, :, None]
    ci = kcol_idx[None, :, None, :]
    kg = k_grid[:, :, ri, ci]
    vg = v_grid[:, :, ri, ci]
    sc = jnp.einsum('bhrnqd,bhrnwkd->bhrnqwk', qg, kg).astype(jnp.float32) * (d ** -0.5) + bias[None]
    p = jax.nn.softmax(sc, axis=(-2, -1))
    o = jnp.einsum('bhrnqwk,bhrnwkd->bhrnqd', p.astype(v.dtype), vg)
    return o.reshape(b, h, s, d)


def memory_attention(q, mk, mv):
    sc = jnp.einsum('bhsd,bhmd->bhsm', q, mk).astype(jnp.float32) * (q.shape[-1] ** -0.5)
    p = jax.nn.softmax(sc, axis=-1)
    return jnp.einsum('bhsm,bhmd->bhsd', p.astype(mv.dtype), mv)


def hybrid_layer(x, mem, norm_mix_g, norm_mem_g, w_in, w_gate, ret_decay_fwd, ret_decay_bwd,
                 ret_norm_g, pool_w, pool_scale, na_q_norm_g, na_k_norm_g, na_rpb,
                 mem_q_norm_g, mem_k_norm_g, w_mem_kv, w_branch, w_out, norm_ffn_g,
                 w_ffn_in, w_ffn_out):
    b, s, dm = x.shape
    h = rms_norm(x, norm_mix_g)
    proj = h @ w_in
    rq, rk, rv, rg, pv, nq, nk, nv, mq = jnp.split(proj, 9, axis=-1)

    pos = jnp.arange(s, dtype=jnp.float32)
    rq_h = rotary(split_heads(rq, RET_HEADS), pos) * (HEAD_DIM ** -0.5)
    rk_h = rotary(split_heads(rk, RET_HEADS), pos)
    ret = bidirectional_retention(rq_h, rk_h, split_heads(rv, RET_HEADS),
                                  jax.nn.log_sigmoid(ret_decay_fwd.astype(jnp.float32)),
                                  jax.nn.log_sigmoid(ret_decay_bwd.astype(jnp.float32)))
    ret = merge_heads(rms_norm(ret, ret_norm_g.reshape(RET_HEADS, 1, HEAD_DIM))) * jax.nn.silu(rg)

    pool = multiscale_pool(pv, pool_w, pool_scale)

    na = merge_heads(neighbourhood_attention(rms_norm(split_heads(nq, NA_HEADS), na_q_norm_g),
                                             rms_norm(split_heads(nk, NA_HEADS), na_k_norm_g),
                                             split_heads(nv, NA_HEADS), na_rpb))

    mk, mv = jnp.split(rms_norm(mem, norm_mem_g) @ w_mem_kv, 2, axis=-1)
    mo = merge_heads(memory_attention(rms_norm(split_heads(mq, MEM_HEADS), mem_q_norm_g),
                                      rms_norm(split_heads(mk, MEM_HEADS), mem_k_norm_g),
                                      split_heads(mv, MEM_HEADS)))

    branches = jnp.stack([ret, pool, na, mo], axis=2)
    up = jnp.einsum('bsnc,ncd->bsnd', branches, w_branch)
    gates = jax.nn.sigmoid(h @ w_gate).reshape(b, s, N_BRANCH, dm)
    merged = jnp.einsum('bsnd,bsnd->bsd', gates, up)
    x = x + merged @ w_out

    a, g = jnp.split(rms_norm(x, norm_ffn_g) @ w_ffn_in, 2, axis=-1)
    return x + (jax.nn.silu(a) * g) @ w_ffn_out


def setup_inputs(seed: int = 0) -> dict:
    key = jax.random.key(seed)
    ks = jax.random.split(key, 22)
    f32 = jnp.float32
    L, D, BW = DEPTH, D_MODEL, BRANCH_WIDTH

    def nrm(k, shape, scale):
        return jax.random.normal(k, shape, f32) * scale

    base_logit = jnp.log(2.0 ** (5.0 + jnp.arange(RET_HEADS, dtype=f32)) - 1.0)
    return {
        "x": nrm(ks[0], (BATCH, SEQ, D), 1.0),
        "mem": nrm(ks[1], (BATCH, N_MEM, D), 1.0),
        "norm_mix_g": 1.0 + nrm(ks[2], (L, D), 0.02),
        "norm_mem_g": 1.0 + nrm(ks[3], (L, D), 0.02),
        "w_in": nrm(ks[4], (L, D, IN_WIDTH), D ** -0.5),
        "w_gate": nrm(ks[5], (L, D, N_BRANCH * D), D ** -0.5),
        "ret_decay_fwd": base_logit[None, :] + nrm(ks[6], (L, RET_HEADS), 0.1),
        "ret_decay_bwd": base_logit[None, :] + nrm(ks[7], (L, RET_HEADS), 0.1),
        "ret_norm_g": 1.0 + nrm(ks[8], (L, BW), 0.02),
        "pool_w": nrm(ks[9], (L, POOL_GROUPS, POOL_GROUP_DIM, POOL_GROUP_DIM), POOL_GROUP_DIM ** -0.5),
        "pool_scale": 1.0 + nrm(ks[10], (L, BW), 0.02),
        "na_q_norm_g": 1.0 + nrm(ks[11], (L, HEAD_DIM), 0.02),
        "na_k_norm_g": 1.0 + nrm(ks[12], (L, HEAD_DIM), 0.02),
        "na_rpb": nrm(ks[13], (L, NA_HEADS, 2 * NA_WIN_ROWS - 1, 2 * NA_WIN_COLS - 1), 0.02),
        "mem_q_norm_g": 1.0 + nrm(ks[14], (L, HEAD_DIM), 0.02),
        "mem_k_norm_g": 1.0 + nrm(ks[15], (L, HEAD_DIM), 0.02),
        "w_mem_kv": nrm(ks[16], (L, D, 2 * BW), D ** -0.5),
        "w_branch": nrm(ks[17], (L, N_BRANCH, BW, D), BW ** -0.5),
        "w_out": nrm(ks[18], (L, D, D), D ** -0.5),
        "norm_ffn_g": 1.0 + nrm(ks[19], (L, D), 0.02),
        "w_ffn_in": nrm(ks[20], (L, D, 2 * FF_HIDDEN), D ** -0.5),
        "w_ffn_out": nrm(ks[21], (L, FF_HIDDEN, D), FF_HIDDEN ** -0.5),
    }


def reference(x, mem, norm_mix_g, norm_mem_g, w_in, w_gate, ret_decay_fwd, ret_decay_bwd,
              ret_norm_g, pool_w, pool_scale, na_q_norm_g, na_k_norm_g, na_rpb,
              mem_q_norm_g, mem_k_norm_g, w_mem_kv, w_branch, w_out, norm_ffn_g,
              w_ffn_in, w_ffn_out):
    for l in range(DEPTH):
        x = hybrid_layer(x, mem, norm_mix_g[l], norm_mem_g[l], w_in[l], w_gate[l],
                         ret_decay_fwd[l], ret_decay_bwd[l], ret_norm_g[l], pool_w[l],
                         pool_scale[l], na_q_norm_g[l], na_k_norm_g[l], na_rpb[l],
                         mem_q_norm_g[l], mem_k_norm_g[l], w_mem_kv[l], w_branch[l],
                         w_out[l], norm_ffn_g[l], w_ffn_in[l], w_ffn_out[l])
    return x
```

```cpp
#include <hip/hip_runtime.h>
#include <hip/hip_cooperative_groups.h>
#include <cstdio>
#include <cstdint>
namespace cg = cooperative_groups;

#ifndef REPM
#define REPM 0
#endif
#ifndef ITM
#define ITM 15
#endif
#ifndef PHM
#define PHM 255
#endif
#ifndef MK_SINGLE
#define MK_SINGLE 1
#endif

#define LAS __attribute__((address_space(3)))
typedef unsigned short bf16_t;
typedef short bf16x8 __attribute__((ext_vector_type(8)));
typedef float f32x4 __attribute__((ext_vector_type(4)));
typedef unsigned u32x4 __attribute__((ext_vector_type(4)));
typedef unsigned u32x2 __attribute__((ext_vector_type(2)));

constexpr int DM = 1024, BATCH = 8, SEQ = 2048, DEPTH = 4, MTOK = BATCH * SEQ, NMEM = 256, INW = 2304, FFH = 2816;
constexpr float EPS = 1e-6f;
constexpr int NPH_LAYER = 7, NPHASES = 1 + DEPTH * NPH_LAYER;

constexpr size_t MiB = 1u << 20;
constexpr size_t WS_W = 0, WS_XB0 = 36 * MiB, WS_BR = 68 * MiB, WS_RA = 100 * MiB, WS_MEMB = 228 * MiB, WS_SSQ0 = 232 * MiB, WS_SSQ1 = 233 * MiB,
                 WS_SSQM = 234 * MiB, WS_POOLW = 235 * MiB, WS_CTR = 235 * MiB + 512 * 1024, WS_MG = 236 * MiB, WS_W1 = 268 * MiB, WS_END = 304 * MiB;
constexpr size_t WO_IN = 0, WO_G = 2359296, WO_B = 6553600, WO_O = 7602176, WO_FI = 8650752, WO_FO = 14417920, WO_M = 17301504;
constexpr size_t RA_SLOT = 8 * MiB;
constexpr size_t RA_QR = 0, RA_KR = 8 * MiB, RA_VRT = 16 * MiB, RA_GR = 24 * MiB, RA_PV = 32 * MiB, RA_NQ = 40 * MiB, RA_NK = 48 * MiB, RA_NVT = 56 * MiB,
                 RA_MQ = 64 * MiB, RA_KRT = 72 * MiB, RA_MK = 80 * MiB, RA_MVT = 81 * MiB, RA_KVS = 82 * MiB;
constexpr size_t RA_UP = 0, RA_ACT = 0, RA_XB1 = 96 * MiB;
constexpr int LDS_BYTES = 131072 + 64;
constexpr size_t WS_BAR = 235 * MiB + 768 * 1024;

__device__ __forceinline__ unsigned cvt_pk_bf16(float lo, float hi) { unsigned r; asm("v_cvt_pk_bf16_f32 %0, %1, %2" : "=v"(r) : "v"(lo), "v"(hi)); return r; }
typedef float f32x2_t __attribute__((ext_vector_type(2)));
typedef __bf16 bf16x2_t __attribute__((ext_vector_type(2)));
__device__ __forceinline__ unsigned cvt_pk_bf16_safe(float lo, float hi) { f32x2_t v = {lo, hi}; bf16x2_t b = __builtin_convertvector(v, bf16x2_t); return __builtin_bit_cast(unsigned, b); }
__device__ __forceinline__ float bf2f(unsigned short u) { return __builtin_bit_cast(float, (unsigned)u << 16); }
__device__ __forceinline__ float bflo(unsigned u) { return __builtin_bit_cast(float, u << 16); }
__device__ __forceinline__ float bfhi(unsigned u) { return __builtin_bit_cast(float, u & 0xffff0000u); }
__device__ __forceinline__ bf16x8 ld16(const bf16_t* p) { return *(const bf16x8*)p; }
__device__ __forceinline__ f32x4 mfma16(bf16x8 a, bf16x8 b, f32x4 c) { return __builtin_amdgcn_mfma_f32_16x16x32_bf16(a, b, c, 0, 0, 0); }
__device__ __forceinline__ float red4(float v) { v += __shfl_xor(v, 16); v += __shfl_xor(v, 32); return v; }
__device__ __forceinline__ float max4(float v) { v = fmaxf(v, __shfl_xor(v, 16)); v = fmaxf(v, __shfl_xor(v, 32)); return v; }
__device__ __forceinline__ float wave_sum(float v) {
#pragma unroll
    for (int o = 1; o < 64; o <<= 1) v += __shfl_xor(v, o);
    return v;
}
__device__ __forceinline__ bf16x8 pack8(const float* f) {
    u32x4 w; w.x = cvt_pk_bf16(f[0], f[1]); w.y = cvt_pk_bf16(f[2], f[3]); w.z = cvt_pk_bf16(f[4], f[5]); w.w = cvt_pk_bf16(f[6], f[7]);
    return __builtin_bit_cast(bf16x8, w);
}
__device__ __forceinline__ bf16x8 pack8_safe(const float* f) {
    u32x4 w; w.x = cvt_pk_bf16_safe(f[0], f[1]); w.y = cvt_pk_bf16_safe(f[2], f[3]); w.z = cvt_pk_bf16_safe(f[4], f[5]); w.w = cvt_pk_bf16_safe(f[6], f[7]);
    return __builtin_bit_cast(bf16x8, w);
}
__device__ __forceinline__ void unpack8(bf16x8 v, float* f) {
    u32x4 w = __builtin_bit_cast(u32x4, v);
    f[0] = bflo(w.x); f[1] = bfhi(w.x); f[2] = bflo(w.y); f[3] = bfhi(w.y); f[4] = bflo(w.z); f[5] = bfhi(w.z); f[6] = bflo(w.w); f[7] = bfhi(w.w);
}
__device__ __forceinline__ void st4bf(bf16_t* p, float a, float b, float c, float d) { u32x2 w; w.x = cvt_pk_bf16(a, b); w.y = cvt_pk_bf16(c, d); *(u32x2*)p = w; }
__device__ __forceinline__ void st4bf_safe(bf16_t* p, float a, float b, float c, float d) { u32x2 w; w.x = cvt_pk_bf16_safe(a, b); w.y = cvt_pk_bf16_safe(c, d); *(u32x2*)p = w; }
__device__ __forceinline__ float sig2_(float y) { return __builtin_amdgcn_rcpf(1.f + __builtin_amdgcn_exp2f(y)); }
__device__ __forceinline__ float sigmoidf_(float x) { return __builtin_amdgcn_rcpf(1.f + __expf(-x)); }

namespace pg8 {
constexpr int BM = 256, BK = 64, HALF = 128, HTB = HALF * BK * 2, NXCD = 8, WGM = 8;
__host__ __device__ __forceinline__ int lds_byte(int r, int c) { const int st = (r >> 4) * 2 + (c >> 5), rr = r & 15, cc = c & 31, ob = rr * 64 + cc * 2; return st * 1024 + (ob ^ (((ob >> 9) & 1) << 5)); }
__host__ __device__ __forceinline__ void stage_rc(int b, int& R, int& C) { const int st = b / 1024, sb = b % 1024, swz = sb ^ (((sb >> 9) & 1) << 5); R = (st >> 1) * 16 + swz / 64; C = (st & 1) * 32 + (swz % 64) / 2; }

struct Unit { int pm, pn, g; };
struct Gemm { const bf16_t* A; const bf16_t* Bt; int lda, ldb, K; unsigned gA, gB; };

struct StaticOrder {
    int nM, nN, nNg, nwg, G, c;
    __device__ void init(int nM_, int nNtot, int nNg_, int G_, int c_) { nM = nM_; nN = nNtot; nNg = nNg_; nwg = nM * nN; G = G_; c = c_; }
    __device__ bool next(int i, Unit& u) const {
        const int L = i * G + c; if (L >= nwg) return false;
        int wgid = L; { const int q = nwg / NXCD, r = nwg % NXCD, xcd = wgid % NXCD, off = wgid / NXCD; wgid = (xcd < r ? xcd * (q + 1) : r * (q + 1) + (xcd - r) * q) + off; }
        const int nig = WGM * nN, gid = wgid / nig, fm = gid * WGM, gsz = (nM - fm) < WGM ? (nM - fm) : WGM;
        u.pm = fm + ((wgid % nig) % gsz); const int pnt = (wgid % nig) / gsz; u.g = pnt / nNg; u.pn = pnt % nNg; return true;
    }
};

struct BlockOrder {
    int pm, pn0, pnstep, g0, gstep, n;
    __device__ bool next(int i, Unit& u) const { if (i >= n) return false; u.pm = pm; u.pn = pn0 + i * pnstep; u.g = g0 + i * gstep; return true; }
};
template <class Epi, bool ALIGN_EPI, class Sched>
__device__ __forceinline__ void gemm_phase(LAS unsigned char* lds, const Gemm g, const Sched& S, const Epi& E, int tid) {
    asm volatile("" : "+v"(tid));
    const int wid = __builtin_amdgcn_readfirstlane(tid >> 6), lane = tid & 63, wr = wid >> 2, wc = wid & 3, fr = lane & 15, fq = lane >> 4;
    const int K = g.K, nt = K / BK;
    unsigned voff[2];
#pragma unroll
    for (int i = 0; i < 2; ++i) { int R, C; stage_rc(tid * 16 + i * 8192, R, C); voff[i] = (unsigned)(R * g.lda + C) * 2u; }
    const unsigned kstep = (unsigned)(BK * 2);
    const unsigned hstepA = (unsigned)HALF * g.lda * 2;
#define hstepB hstepA
    const unsigned ldsw = (unsigned)wid * 1024u;
    const int aoff = lds_byte(wr * 64 + fr, fq * 8), boff = lds_byte(wc * 32 + fr, fq * 8);
#define PG8_SA(b, h) (((b) * 2 + (h)) * HTB)
#define PG8_SB(b, h) ((4 + (b) * 2 + (h)) * HTB)
#define voffA g.A
#define voffB g.Bt
#define PG8_STAGE(bufoff, gbase, mat) do { _Pragma("unroll") for (int _i = 0; _i < 2; ++_i) \
        __builtin_amdgcn_global_load_lds((const unsigned*)((const char*)(mat) + (size_t)(gbase) + voff[_i]), (LAS unsigned*)(lds + (bufoff) + ldsw + _i * 8192), 16, 0, 0); } while (0)
#define PG8_LDA(dst, b, h) do { _Pragma("unroll") for (int m = 0; m < 4; ++m) _Pragma("unroll") for (int k = 0; k < 2; ++k) dst[m][k] = *(const LAS bf16x8*)(lds + PG8_SA(b, h) + aoff + m * 2048 + k * 1024); } while (0)
#define PG8_LDB(dst, b, h) do { _Pragma("unroll") for (int n = 0; n < 2; ++n) _Pragma("unroll") for (int k = 0; k < 2; ++k) dst[n][k] = *(const LAS bf16x8*)(lds + PG8_SB(b, h) + boff + n * 2048 + k * 1024); } while (0)
#define PG8_MMA(ai, bj, At, Bt) do { __builtin_amdgcn_s_setprio(1); _Pragma("unroll") for (int m = 0; m < 4; ++m) _Pragma("unroll") for (int n = 0; n < 2; ++n) _Pragma("unroll") for (int k = 0; k < 2; ++k) \
        acc[ai][bj][m][n] = __builtin_amdgcn_mfma_f32_16x16x32_bf16(Bt[n][k], At[m][k], acc[ai][bj][m][n], 0, 0, 0); __builtin_amdgcn_s_setprio(0); } while (0)
#define PG8_WAIT_V(n) asm volatile("s_waitcnt vmcnt(" #n ")" ::: "memory")
#define PG8_WAIT_L(n) asm volatile("s_waitcnt lgkmcnt(" #n ")" ::: "memory")
#define PG8_BAR __builtin_amdgcn_s_barrier()
#define PG8_SCHED __builtin_amdgcn_sched_barrier(0)
#define PG8_ABASE(u) (((unsigned)(u).g * (unsigned)g.gA + (unsigned)(u).pm * BM * g.lda) * 2u)
#define PG8_BBASE(u) (((unsigned)(u).g * (unsigned)g.gB + (unsigned)(u).pn * BM * g.ldb) * 2u)
    Unit cur, nxt; int ui = 0;
    if (!S.next(0, cur)) return;
    f32x4 acc[2][2][4][2];
#pragma unroll
    for (int a = 0; a < 2; ++a)
#pragma unroll
        for (int b = 0; b < 2; ++b)
#pragma unroll
            for (int m = 0; m < 4; ++m)
#pragma unroll
                for (int n = 0; n < 2; ++n) acc[a][b][m][n] = (f32x4){0.f, 0.f, 0.f, 0.f};
    bf16x8 At[4][2], B0[2][2], B1[2][2];
    unsigned cA = PG8_ABASE(cur), cB = PG8_BBASE(cur);
    PG8_STAGE(PG8_SB(0, 0), cB, voffB); PG8_STAGE(PG8_SB(0, 1), cB + hstepB, voffB); PG8_STAGE(PG8_SA(0, 0), cA, voffA); PG8_STAGE(PG8_SA(0, 1), cA + hstepA, voffA);
    if (wr == 1) PG8_BAR;
    PG8_WAIT_V(2); PG8_BAR;
    PG8_STAGE(PG8_SB(1, 0), cB + kstep, voffB); PG8_STAGE(PG8_SA(1, 0), cA + kstep, voffA); PG8_STAGE(PG8_SB(1, 1), cB + hstepB + kstep, voffB);
    PG8_WAIT_V(6); PG8_BAR;
    for (;;) {
        const bool has_next = S.next(ui + 1, nxt);
        const unsigned nA = has_next ? PG8_ABASE(nxt) : cA, nB = has_next ? PG8_BBASE(nxt) : cB;
        for (int t = 0; t < nt; t += 2) {
            const bool last = (t == nt - 2);
            const unsigned a1 = cA + (unsigned)(t + 1) * kstep;
            const unsigned a2 = last ? nA : cA + (unsigned)(t + 2) * kstep, b2 = last ? nB : cB + (unsigned)(t + 2) * kstep;
            const unsigned a3 = a2 + kstep, b3 = b2 + kstep;
            PG8_LDB(B0, 0, 0); PG8_LDB(B1, 0, 1); PG8_SCHED; PG8_LDA(At, 0, 0); PG8_STAGE(PG8_SA(1, 1), a1 + hstepA, voffA);
            PG8_WAIT_V(8); PG8_WAIT_L(0); PG8_BAR; PG8_MMA(0, 0, At, B0); PG8_MMA(0, 1, At, B1); PG8_BAR; PG8_SCHED;
            PG8_LDA(At, 0, 1); PG8_STAGE(PG8_SB(0, 0), b2, voffB); PG8_STAGE(PG8_SB(0, 1), b2 + hstepB, voffB); PG8_STAGE(PG8_SA(0, 0), a2, voffA);
            PG8_WAIT_V(8); PG8_WAIT_L(0); PG8_BAR; PG8_MMA(1, 0, At, B0); PG8_MMA(1, 1, At, B1); PG8_BAR; PG8_SCHED;
            PG8_LDB(B0, 1, 0); PG8_LDB(B1, 1, 1); PG8_SCHED; PG8_LDA(At, 1, 0); PG8_STAGE(PG8_SA(0, 1), a2 + hstepA, voffA);
            PG8_WAIT_V(8); PG8_WAIT_L(0); PG8_BAR; PG8_MMA(0, 0, At, B0); PG8_MMA(0, 1, At, B1); PG8_BAR; PG8_SCHED;
            PG8_LDA(At, 1, 1); PG8_STAGE(PG8_SB(1, 0), b3, voffB); PG8_STAGE(PG8_SB(1, 1), b3 + hstepB, voffB); PG8_STAGE(PG8_SA(1, 0), a3, voffA);
            PG8_WAIT_V(8); PG8_WAIT_L(0); PG8_BAR; PG8_MMA(1, 0, At, B0); PG8_MMA(1, 1, At, B1); PG8_BAR; PG8_SCHED;
        }
        if constexpr (ALIGN_EPI) { if (wr == 0) PG8_BAR; }
        { int frl = fr, fql = fq; asm volatile("" : "+v"(frl), "+v"(fql)); E(acc, cur, wr, wc, frl, fql); }
        if (!has_next) break;
#pragma unroll
        for (int a = 0; a < 2; ++a)
#pragma unroll
            for (int b = 0; b < 2; ++b)
#pragma unroll
                for (int m = 0; m < 4; ++m)
#pragma unroll
                    for (int n = 0; n < 2; ++n) acc[a][b][m][n] = (f32x4){0.f, 0.f, 0.f, 0.f};
        cur = nxt; cA = nA; cB = nB; ++ui;
        if constexpr (ALIGN_EPI) { if (wr == 1) PG8_BAR; }
    }
    PG8_WAIT_V(0);
    if constexpr (!ALIGN_EPI) { if (wr == 0) PG8_BAR; }
    PG8_BAR;
#undef PG8_SA
#undef PG8_SB
#undef PG8_STAGE
#undef PG8_LDA
#undef PG8_LDB
#undef PG8_MMA
#undef PG8_WAIT_V
#undef PG8_WAIT_L
#undef PG8_BAR
#undef PG8_SCHED
#undef PG8_ABASE
#undef voffA
#undef voffB
#undef hstepB
#undef PG8_BBASE
}
}
struct Args { const float* in[22]; float* out; unsigned char* ws; int ph_lo, ph_hi; };
enum { I_X = 0, I_MEM, I_NMIX, I_NMEM, I_WIN, I_WGATE, I_RDF, I_RDB, I_RNG, I_POOLW, I_POOLS, I_NAQ, I_NAK, I_RPB, I_MQG, I_MKG, I_WMKV, I_WBR, I_WOUT, I_NFFN, I_WFI, I_WFO };

typedef f32x4 Acc[2][2][4][2];

__device__ __forceinline__ void row_rinv(const float* ssq, int row0, int fq, float (&rinv)[2][4]) {
#pragma unroll
    for (int ai = 0; ai < 2; ++ai)
#pragma unroll
        for (int m = 0; m < 4; ++m) {
            const f32x4 v = *(const f32x4*)(ssq + (size_t)(row0 + ai * 128 + m * 16) * 16 + fq * 4);
            const float s = red4((v.x + v.y) + (v.z + v.w));
            rinv[ai][m] = rsqrtf(s * (1.f / DM) + EPS);
        }
}

struct EpiHead {
    const __attribute__((address_space(4))) Args* ap; int l; int memkv; int slen;
    __device__ __forceinline__ void operator()(const Acc& acc, const pg8::Unit& u, int wr, int wc, int fr, int fq) const {
        unsigned char* ra = ap->ws + WS_RA;
        float rinv[2][4]; row_rinv((const float*)(ap->ws + (memkv ? WS_SSQM : WS_SSQ0)), u.pm * 256 + wr * 64 + fr, fq, rinv);
        const int tpb = slen >> 8;
        const int b = u.pm / tpb, s0 = (u.pm % tpb) * 256 + wr * 64 + fr, bh = b * 4 + wc;
        int mode; float scale = 1.f; const float* gv = nullptr; bf16_t* dst = nullptr; bf16_t* dstT = nullptr;
        const int pn = u.pn;
        if (memkv) {
            if (pn == 0) { mode = 3; gv = ap->in[I_MKG] + l * 64; dst = (bf16_t*)(ra + RA_MK); } else { mode = 2; dstT = (bf16_t*)(ra + RA_MVT); }
        } else {
            dst = (bf16_t*)(ra + (size_t)pn * RA_SLOT);
            if (pn == 0) { mode = 1; scale = 0.125f; }
            else if (pn == 1) { mode = 1; dstT = (bf16_t*)(ra + RA_KRT); }
            else if (pn == 2 || pn == 7 || pn == 4) { mode = 2; dstT = dst; }
            else if (pn == 3) { mode = 0; }
            else { mode = 3; gv = ap->in[(pn == 5) ? I_NAQ : (pn == 6 ? I_NAK : I_MQG)] + l * 64; scale = (pn == 6) ? 1.f : 0.125f; }
        }
#pragma unroll
        for (int ai = 0; ai < 2; ++ai)
#pragma unroll
            for (int m = 0; m < 4; ++m) {
                const int s = s0 + ai * 128 + m * 16;
                float v[2][2][4];
#pragma unroll
                for (int bj = 0; bj < 2; ++bj)
#pragma unroll
                    for (int n = 0; n < 2; ++n)
#pragma unroll
                        for (int j = 0; j < 4; ++j) v[bj][n][j] = acc[ai][bj][m][n][j] * rinv[ai][m];
                if (mode == 1) {
#pragma unroll
                    for (int n = 0; n < 2; ++n)
#pragma unroll
                        for (int j = 0; j < 4; ++j) {
                            const int i = 16 * n + 4 * fq + j;
                            const float inv = exp2f(-(float)i * (13.287712379549449f / 32.f));
                            const float fr_ = __builtin_amdgcn_fractf((float)s * inv * 0.15915494309189535f);
                            const float sn = __builtin_amdgcn_sinf(fr_), cs = __builtin_amdgcn_cosf(fr_);
                            const float t1 = v[0][n][j], t2 = v[1][n][j];
                            v[0][n][j] = (t1 * cs - t2 * sn) * scale; v[1][n][j] = (t1 * sn + t2 * cs) * scale;
                        }
                } else if (mode == 3) {
                    float q = 0.f;
#pragma unroll
                    for (int bj = 0; bj < 2; ++bj)
#pragma unroll
                        for (int n = 0; n < 2; ++n)
#pragma unroll
                            for (int j = 0; j < 4; ++j) q += v[bj][n][j] * v[bj][n][j];
                    q = red4(q);
                    const float rn = rsqrtf(q * (1.f / 64.f) + EPS) * scale;
#pragma unroll
                    for (int bj = 0; bj < 2; ++bj)
#pragma unroll
                        for (int n = 0; n < 2; ++n) {
                            const f32x4 gg = *(const f32x4*)(gv + 32 * bj + 16 * n + 4 * fq);
#pragma unroll
                            for (int j = 0; j < 4; ++j) v[bj][n][j] *= rn * gg[j];
                        }
                }
                if (mode != 2) {
                    bf16_t* p = dst + ((size_t)bh * slen + s) * 64 + 4 * fq;
#pragma unroll
                    for (int bj = 0; bj < 2; ++bj)
#pragma unroll
                        for (int n = 0; n < 2; ++n) st4bf(p + 32 * bj + 16 * n, v[bj][n][0], v[bj][n][1], v[bj][n][2], v[bj][n][3]);
                }
                if (dstT) {
                    bf16_t* p = dstT + ((size_t)bh * 64 + 4 * fq) * slen + s;
#pragma unroll
                    for (int bj = 0; bj < 2; ++bj)
#pragma unroll
                        for (int n = 0; n < 2; ++n)
#pragma unroll
                            for (int j = 0; j < 4; ++j) p[(size_t)(32 * bj + 16 * n + j) * slen] = (bf16_t)(cvt_pk_bf16(v[bj][n][j], 0.f) & 0xffffu);
                }
            }
    }
};

__device__ __forceinline__ size_t up_slot(int su, int n, int ai, int m, int bj, int nn, int wave, int lane) {
    return ((((((((size_t)su * 4 + n) * 2 + ai) * 4 + m) * 2 + bj) * 2 + nn) * 8 + wave) * 64 + lane) * 4;
}
struct EpiUp {
    bf16_t* up;
    __device__ __forceinline__ void operator()(const Acc& acc, const pg8::Unit& u, int wr, int wc, int fr, int fq) const {
        const int su = u.pm * 4 + u.pn, wave = wr * 4 + wc, lane = fq * 16 + fr;
#pragma unroll
        for (int ai = 0; ai < 2; ++ai)
#pragma unroll
            for (int m = 0; m < 4; ++m)
#pragma unroll
                for (int bj = 0; bj < 2; ++bj)
#pragma unroll
                    for (int n = 0; n < 2; ++n) { const f32x4 a = acc[ai][bj][m][n]; st4bf_safe(up + up_slot(su, u.g, ai, m, bj, n, wave, lane), a[0], a[1], a[2], a[3]); }
    }
};

struct EpiGate {
    const float* ssq; const bf16_t* up; bf16_t* mg;
    __device__ __forceinline__ void operator()(const Acc& acc, const pg8::Unit& u, int wr, int wc, int fr, int fq) const {
        float rinv[2][4]; const int row0 = u.pm * 256 + wr * 64 + fr; row_rinv(ssq, row0, fq, rinv);
        const int d = u.pn * 64 + 16 * wc + 4 * fq;
#pragma unroll
        for (int ai = 0; ai < 2; ++ai)
#pragma unroll
            for (int m = 0; m < 4; ++m) {
                const size_t r = (size_t)(row0 + ai * 128 + m * 16);
                const int su = u.pm * 4 + (u.pn >> 2), pgl = u.pn & 3, wsrc = wr * 4 + (pgl & 1) * 2 + (wc >> 1), lane = fq * 16 + fr;
                const unsigned long long q0 = __hip_atomic_load((const unsigned long long*)(up + up_slot(su, 0, ai, m, pgl >> 1, wc & 1, wsrc, lane)), __ATOMIC_RELAXED, __HIP_MEMORY_SCOPE_AGENT),
                                         q1 = __hip_atomic_load((const unsigned long long*)(up + up_slot(su, 1, ai, m, pgl >> 1, wc & 1, wsrc, lane)), __ATOMIC_RELAXED, __HIP_MEMORY_SCOPE_AGENT),
                                         q2 = __hip_atomic_load((const unsigned long long*)(up + up_slot(su, 2, ai, m, pgl >> 1, wc & 1, wsrc, lane)), __ATOMIC_RELAXED, __HIP_MEMORY_SCOPE_AGENT),
                                         q3 = __hip_atomic_load((const unsigned long long*)(up + up_slot(su, 3, ai, m, pgl >> 1, wc & 1, wsrc, lane)), __ATOMIC_RELAXED, __HIP_MEMORY_SCOPE_AGENT);
                const u32x2 w0 = {(unsigned)q0, (unsigned)(q0 >> 32)}, w1 = {(unsigned)q1, (unsigned)(q1 >> 32)}, w2 = {(unsigned)q2, (unsigned)(q2 >> 32)}, w3 = {(unsigned)q3, (unsigned)(q3 >> 32)};
                const float rn2 = rinv[ai][m] * -1.4426950408889634f;
                const unsigned uu[8] = {w0.x, w0.y, w1.x, w1.y, w2.x, w2.y, w3.x, w3.y};
                float o[4] = {0.f, 0.f, 0.f, 0.f};
#pragma unroll
                for (int n = 0; n < 4; ++n) {
                    const f32x4 a = acc[ai][n >> 1][m][n & 1];
                    o[0] += sig2_(a[0] * rn2) * bflo(uu[2 * n]); o[1] += sig2_(a[1] * rn2) * bfhi(uu[2 * n]);
                    o[2] += sig2_(a[2] * rn2) * bflo(uu[2 * n + 1]); o[3] += sig2_(a[3] * rn2) * bfhi(uu[2 * n + 1]);
                }
                st4bf(mg + r * DM + d, o[0], o[1], o[2], o[3]);
            }
    }
};

struct EpiResid {
    const float* xin; float* xout; bf16_t* xb; float* ssq; int write_xb;
    __device__ __forceinline__ void operator()(const Acc& acc, const pg8::Unit& u, int wr, int wc, int fr, int fq) const {
        const int row0 = u.pm * 256 + wr * 64 + fr;
#pragma unroll
        for (int ai = 0; ai < 2; ++ai)
#pragma unroll
            for (int m = 0; m < 4; ++m) {
                const size_t r = (size_t)(row0 + ai * 128 + m * 16);
                float part = 0.f;
#pragma unroll
                for (int bj = 0; bj < 2; ++bj)
#pragma unroll
                    for (int n = 0; n < 2; ++n) {
                        const int c = u.pn * 256 + 128 * bj + 32 * wc + 16 * n + 4 * fq;
                        f32x4 v = *(const f32x4*)(xin + r * DM + c) + acc[ai][bj][m][n];
                        *(f32x4*)(xout + r * DM + c) = v;
                        if (write_xb) st4bf(xb + r * DM + c, v[0], v[1], v[2], v[3]);
                        part += (v[0] * v[0] + v[1] * v[1]) + (v[2] * v[2] + v[3] * v[3]);
                    }
                part = red4(part);
                if (fq == 0 && write_xb) ssq[r * 16 + u.pn * 4 + wc] = part;
            }
    }
};

struct EpiSwiglu {
    const float* ssq; bf16_t* act;
    __device__ __forceinline__ void operator()(const Acc& acc, const pg8::Unit& u, int wr, int wc, int fr, int fq) const {
        float rinv[2][4]; const int row0 = u.pm * 256 + wr * 64 + fr; row_rinv(ssq, row0, fq, rinv);
#pragma unroll
        for (int ai = 0; ai < 2; ++ai)
#pragma unroll
            for (int m = 0; m < 4; ++m) {
                const size_t r = (size_t)(row0 + ai * 128 + m * 16); const float ri = rinv[ai][m];
                float o[8];
#pragma unroll
                for (int bj = 0; bj < 2; ++bj)
#pragma unroll
                    for (int j = 0; j < 4; ++j) { const float a = acc[ai][bj][m][0][j] * ri, gg = acc[ai][bj][m][1][j] * ri; o[4 * bj + j] = a * sigmoidf_(a) * gg; }
                u32x4 w; w.x = cvt_pk_bf16(o[0], o[1]); w.y = cvt_pk_bf16(o[2], o[3]); w.z = cvt_pk_bf16(o[4], o[5]); w.w = cvt_pk_bf16(o[6], o[7]);
                *(u32x4*)(act + r * FFH + u.pn * 128 + 32 * wc + 8 * fq) = w;
            }
    }
};

__device__ __forceinline__ int map_col(int maptype, int rho) {
    const int t = rho >> 8, c = rho & 255;
    if (maptype == 1) return t * 256 + ((c >> 5) & 3) * 64 + ((c >> 7) & 1) * 32 + (c & 31);
    if (maptype == 2) { const int n = 2 * (c >> 7) + ((c >> 4) & 1), dl = ((c >> 5) & 3) * 16 + (c & 15); return n * 1024 + t * 64 + dl; }
    if (maptype == 3) { const int nn = (c >> 4) & 1, hh = t * 128 + ((c >> 7) & 1) * 64 + ((c >> 5) & 3) * 16 + (c & 15); return nn * FFH + hh; }
    return rho;
}
__device__ __forceinline__ int kperm128(int kp) { return (kp & ~127) + ((kp >> 2) & 1) * 64 + ((kp >> 5) & 3) * 16 + ((kp >> 3) & 3) * 4 + (kp & 3); }
__device__ __forceinline__ void cvt_item(const float* W, int K, int ldn, int nrows, bf16_t* WT, int maptype, const float* gain, LAS unsigned* scr, int item, int lane, int kperm = 0) {
    const int nblk = nrows >> 6, kb = item / nblk, nb = item - kb * nblk, k0 = 64 * kb, n0 = 64 * nb;
    const int l15 = lane & 15, kq = lane >> 4;
    const float* src = W + map_col(maptype, n0 + 4 * l15);
    f32x4 a[8], b[8];
#pragma unroll
    for (int i = 0; i < 8; ++i) { const int k = k0 + 8 * i + 2 * kq; const int ka = kperm ? kperm128(k) : k, kb2 = kperm ? kperm128(k + 1) : k + 1;
        a[i] = *(const f32x4*)(src + (size_t)ka * ldn); b[i] = *(const f32x4*)(src + (size_t)kb2 * ldn); }
#pragma unroll
    for (int i = 0; i < 8; ++i) { const int k = 8 * i + 2 * kq;
        if (gain) { const float g0 = gain[k0 + k], g1 = gain[k0 + k + 1]; a[i] = a[i] * g0; b[i] = b[i] * g1; }
#pragma unroll
        for (int q = 0; q < 4; ++q) scr[(4 * l15 + q) * 36 + (k >> 1)] = cvt_pk_bf16(a[i][q], b[i][q]); }
    asm volatile("s_waitcnt lgkmcnt(0)" ::: "memory");
    const int c = lane & 7;
#pragma unroll
    for (int j = 0; j < 8; ++j) { const int n = (lane >> 3) + 8 * j;
        *(u32x4*)(WT + (size_t)(n0 + n) * K + k0 + 8 * c) = *(const LAS u32x4*)(scr + n * 36 + 4 * c); }
    asm volatile("s_waitcnt lgkmcnt(0)" ::: "memory");
}
constexpr int CI_IN = 16 * 36, CI_G = 16 * 64, CI_B = 4 * 16, CI_O = 16 * 16, CI_FI = 16 * 88, CI_FO = 44 * 16, CI_M = 16 * 8;
constexpr int CI_TOTAL = CI_IN + CI_G + 4 * CI_B + CI_O + CI_FI + CI_FO + CI_M;
__device__ __forceinline__ void cvt_layer_item(const __attribute__((address_space(4))) Args* ap, int l, bf16_t* Wt, LAS unsigned* scr, int item, int lane) {
    int r = item, K = DM, ldn, nrows, mt = 0, kp = 0; const float* W; bf16_t* WT; const float* gain = nullptr;
    if (r < CI_IN) { W = ap->in[I_WIN] + (size_t)l * DM * INW; ldn = INW; nrows = INW; WT = Wt + WO_IN; mt = 1; gain = ap->in[I_NMIX] + (size_t)l * DM; }
    else if ((r -= CI_IN) < CI_G) { W = ap->in[I_WGATE] + (size_t)l * DM * 4096; ldn = 4096; nrows = 4096; WT = Wt + WO_G; mt = 2; gain = ap->in[I_NMIX] + (size_t)l * DM; }
    else if ((r -= CI_G) < 4 * CI_B) { const int nb = r / CI_B; r -= nb * CI_B; W = ap->in[I_WBR] + ((size_t)l * 4 + nb) * 256 * DM; K = 256; ldn = DM; nrows = DM; WT = Wt + WO_B + (size_t)nb * DM * 256; }
    else if ((r -= 4 * CI_B) < CI_O) { W = ap->in[I_WOUT] + (size_t)l * DM * DM; ldn = DM; nrows = DM; WT = Wt + WO_O; }
    else if ((r -= CI_O) < CI_FI) { W = ap->in[I_WFI] + (size_t)l * DM * 2 * FFH; ldn = 2 * FFH; nrows = 2 * FFH; WT = Wt + WO_FI; mt = 3; gain = ap->in[I_NFFN] + (size_t)l * DM; }
    else if ((r -= CI_FI) < CI_FO) { W = ap->in[I_WFO] + (size_t)l * FFH * DM; K = FFH; ldn = DM; nrows = DM; WT = Wt + WO_FO; kp = 1; }
    else { r -= CI_FO; W = ap->in[I_WMKV] + (size_t)l * DM * 512; ldn = 512; nrows = 512; WT = Wt + WO_M; mt = 1; gain = ap->in[I_NMEM] + (size_t)l * DM; }
    cvt_item(W, K, ldn, nrows, WT, mt, gain, scr, r, lane, kp);
}
__device__ __forceinline__ void row_to_bf16(const float* xrow, bf16_t* orow, float* ssq, int lane) {
    const f32x4* xr = (const f32x4*)xrow + lane; float s = 0.f;
#pragma unroll
    for (int j = 0; j < 4; ++j) { const f32x4 v = xr[64 * j]; s += (v.x * v.x + v.y * v.y) + (v.z * v.z + v.w * v.w); st4bf(orow + (lane + 64 * j) * 4, v.x, v.y, v.z, v.w); }
    s = wave_sum(s);
    if (lane < 16) ssq[lane] = (lane == 0) ? s : 0.f;
}

__device__ __forceinline__ float log2_sigmoid(float x) { return -log1pf(expf(-x)) * 1.4426950408889634f; }

__device__ __forceinline__ void kv_item(const unsigned char* ra, float* kvs, const float* rdf, const float* rdb, int item, int lane) {
    const int fr = lane & 15, fq = lane >> 4;
    const int dir = item & 1, n = (item >> 1) & 15, bh = item >> 5, h = bh & 3;
    const float lg2 = log2_sigmoid(dir ? rdb[h] : rdf[h]);
    const bf16_t* KRT = (const bf16_t*)(ra + RA_KRT); const bf16_t* VRT = (const bf16_t*)(ra + RA_VRT);
    f32x4 kv[4][4];
#pragma unroll
    for (int a = 0; a < 4; ++a)
#pragma unroll
        for (int b = 0; b < 4; ++b) kv[a][b] = (f32x4){0.f, 0.f, 0.f, 0.f};
#pragma unroll 2
    for (int ks = 0; ks < 4; ++ks) {
        const int sb = n * 128 + ks * 32 + fq * 8;
        float w[8];
#pragma unroll
        for (int i = 0; i < 8; ++i) { const int il = ks * 32 + fq * 8 + i; w[i] = exp2f(lg2 * (float)(dir ? il : 127 - il)); }
        bf16x8 kb[4];
#pragma unroll
        for (int dt = 0; dt < 4; ++dt) { float f[8]; unpack8(ld16(KRT + ((size_t)bh * 64 + dt * 16 + fr) * SEQ + sb), f);
#pragma unroll
            for (int i = 0; i < 8; ++i) f[i] *= w[i];
            kb[dt] = pack8(f); }
#pragma unroll
        for (int et = 0; et < 4; ++et) { const bf16x8 va = ld16(VRT + ((size_t)bh * 64 + et * 16 + fr) * SEQ + sb);
#pragma unroll
            for (int dt = 0; dt < 4; ++dt) kv[et][dt] = mfma16(va, kb[dt], kv[et][dt]); }
    }
    float* o = kvs + ((size_t)(dir * 32 + bh) * 16 + n) * 4096;
#pragma unroll
    for (int et = 0; et < 4; ++et)
#pragma unroll
        for (int dt = 0; dt < 4; ++dt)
#pragma unroll
            for (int j = 0; j < 4; ++j) o[(et * 16 + fq * 4 + j) * 64 + dt * 16 + fr] = kv[et][dt][j];
}

template <bool NA>
__device__ __forceinline__ void attn_item(const unsigned char* ra, const LAS float* rpb, bf16_t* brout, int item, int lane) {
    const int fr = lane & 15, fq = lane >> 4;
    int bh, qtok, r = 0, row_start = 0, kc0 = 0, qcol = 0, qwin = 0, h;
    const bf16_t *Q, *Kp, *VT;
    if (NA) { const int cb = item & 3; r = (item >> 2) & 31; bh = item >> 7; h = bh & 3;
        row_start = min(max(r - 4, 0), 24); kc0 = min(max(cb * 16 - 8, 0), 32); qcol = cb * 16 + fr; qwin = min(max(qcol - 8, 0), 48); qtok = r * 64 + cb * 16;
        Q = (const bf16_t*)(ra + RA_NQ); Kp = (const bf16_t*)(ra + RA_NK) + (size_t)bh * SEQ * 64; VT = (const bf16_t*)(ra + RA_NVT) + (size_t)bh * 64 * SEQ;
    } else { bh = item >> 7; h = bh & 3; qtok = (item & 127) * 16;
        Q = (const bf16_t*)(ra + RA_MQ); Kp = (const bf16_t*)(ra + RA_MK) + (size_t)bh * NMEM * 64; VT = (const bf16_t*)(ra + RA_MVT) + (size_t)bh * 64 * NMEM; }
    const int kslen = NA ? SEQ : NMEM;
    const bf16_t* qp = Q + ((size_t)bh * SEQ + qtok + fr) * 64 + fq * 8;
    const bf16x8 q0 = ld16(qp), q1 = ld16(qp + 32);
    const int krel = (fr >> 2) * 8 + (fr & 3);
    bf16x8 kf[8][2][2];
#pragma unroll
    for (int g = 0; g < 8; ++g) {
        const int kbase = NA ? ((row_start + g) * 64 + kc0) : g * 32;
#pragma unroll
        for (int T = 0; T < 2; ++T) { const bf16_t* kp = Kp + (size_t)(kbase + krel + 4 * T) * 64 + fq * 8; kf[g][T][0] = ld16(kp); kf[g][T][1] = ld16(kp + 32); }
    }
    f32x4 sc[8][2];
    bf16x8 vf[8][4];
    float mx = -3.0e38f;
#pragma unroll
    for (int hf = 0; hf < 2; ++hf) {
#pragma unroll
        for (int g = 4 * hf; g < 4 * hf + 4; ++g) {
#pragma unroll
            for (int T = 0; T < 2; ++T) {
                f32x4 a = mfma16(kf[g][T][0], q0, (f32x4){0.f, 0.f, 0.f, 0.f}); a = mfma16(kf[g][T][1], q1, a);
                if (NA) {
                    const LAS float* bp = rpb + (h * 15 + (row_start + g - r + 7)) * 31;
#pragma unroll
                    for (int j = 0; j < 4; ++j) { const int kc = kc0 + fq * 8 + j + 4 * T; const bool ok = (kc >= qwin) && (kc < qwin + 16);
                        const int bi = min(max(kc - qcol + 15, 0), 30);
                        const float bv = bp[bi];
                        a[j] = ok ? a[j] + bv : (-1.0e30f + bv * 0.f); }
                }
                sc[g][T] = a;
                mx = fmaxf(mx, fmaxf(fmaxf(a[0], a[1]), fmaxf(a[2], a[3])));
            }
        }
#pragma unroll
        for (int g = 4 * hf; g < 4 * hf + 4; ++g) {
            const int kbase = NA ? ((row_start + g) * 64 + kc0) : g * 32;
#pragma unroll
            for (int et = 0; et < 4; ++et) vf[g][et] = ld16(VT + (size_t)(et * 16 + fr) * kslen + kbase + fq * 8);
        }
    }
    mx = max4(mx);
    float sum = 0.f;
#pragma unroll
    for (int g = 0; g < 8; ++g)
#pragma unroll
        for (int T = 0; T < 2; ++T)
#pragma unroll
            for (int j = 0; j < 4; ++j) { const float p = __expf(sc[g][T][j] - mx); sc[g][T][j] = p; sum += p; }
    sum = red4(sum);
    f32x4 o[4];
#pragma unroll
    for (int et = 0; et < 4; ++et) o[et] = (f32x4){0.f, 0.f, 0.f, 0.f};
#pragma unroll
    for (int g = 0; g < 8; ++g) {
        float f[8] = {sc[g][0][0], sc[g][0][1], sc[g][0][2], sc[g][0][3], sc[g][1][0], sc[g][1][1], sc[g][1][2], sc[g][1][3]};
        const bf16x8 pb = pack8(f);
#pragma unroll
        for (int et = 0; et < 4; ++et) o[et] = mfma16(vf[g][et], pb, o[et]);
    }
    const float inv = 1.f / sum;
    const int b = bh >> 2;
    bf16_t* op = brout + ((size_t)b * SEQ + qtok + fr) * 256 + h * 64 + fq * 4;
#pragma unroll
    for (int et = 0; et < 4; ++et) st4bf(op + et * 16, o[et][0] * inv, o[et][1] * inv, o[et][2] * inv, o[et][3] * inv);
}

template <bool NA>
__device__ __forceinline__ void attn4_item(const unsigned char* ra, const LAS float* rpb, bf16_t* brout, int item, int lane) {
    const int fr = lane & 15, fq = lane >> 4;
    int bh, kc0 = 0, qcol = 0, qwin = 0, r0 = 0, g_lo = 0, g_hi = 8, qt0;
    const bf16_t *Q, *Kp, *VT;
    if (NA) { const int cb = item & 3; r0 = ((item >> 2) & 7) * 4; bh = item >> 5;
        kc0 = min(max(cb * 16 - 8, 0), 32); qcol = cb * 16 + fr; qwin = min(max(qcol - 8, 0), 48); qt0 = r0 * 64 + cb * 16;
        g_lo = min(max(r0 - 4, 0), 24); g_hi = min(max(r0 - 1, 0), 24) + 8;
        Q = (const bf16_t*)(ra + RA_NQ); Kp = (const bf16_t*)(ra + RA_NK) + (size_t)bh * SEQ * 64; VT = (const bf16_t*)(ra + RA_NVT) + (size_t)bh * 64 * SEQ;
    } else { bh = item >> 5; qt0 = (item & 31) * 64;
        Q = (const bf16_t*)(ra + RA_MQ); Kp = (const bf16_t*)(ra + RA_MK) + (size_t)bh * NMEM * 64; VT = (const bf16_t*)(ra + RA_MVT) + (size_t)bh * 64 * NMEM; }
    const int h = bh & 3, b = bh >> 2;
    const int kslen = NA ? SEQ : NMEM, qstride = NA ? 64 : 16;
    bf16x8 q[4][2];
#pragma unroll
    for (int i = 0; i < 4; ++i) { const bf16_t* qp = Q + ((size_t)bh * SEQ + qt0 + i * qstride + fr) * 64 + fq * 8; q[i][0] = ld16(qp); q[i][1] = ld16(qp + 32); }
    f32x4 o[4][4]; float m[4], l[4];
#pragma unroll
    for (int i = 0; i < 4; ++i) { m[i] = -3.0e38f; l[i] = 0.f;
#pragma unroll
        for (int et = 0; et < 4; ++et) o[i][et] = (f32x4){0.f, 0.f, 0.f, 0.f}; }
    const int krel = (fr >> 2) * 8 + (fr & 3);
    const bf16_t* kpl = Kp + (size_t)krel * 64 + fq * 8;
    const bf16_t* vpl = VT + (size_t)fr * kslen + fq * 8;
#define A4_LOAD(g_, kf_, vf_) do { const int kb_ = NA ? (g_) * 64 + kc0 : (g_) * 32; \
        kf_[0][0] = ld16(kpl + (size_t)kb_ * 64); kf_[0][1] = ld16(kpl + (size_t)kb_ * 64 + 32); kf_[1][0] = ld16(kpl + (size_t)(kb_ + 4) * 64); kf_[1][1] = ld16(kpl + (size_t)(kb_ + 4) * 64 + 32); \
        _Pragma("unroll") for (int et_ = 0; et_ < 4; ++et_) vf_[et_] = ld16(vpl + (size_t)et_ * 16 * kslen + kb_); } while (0)
    bf16x8 kc[2][2], vc[4], kn[2][2], vn[4];
    A4_LOAD(g_lo, kc, vc);
#pragma unroll 1
    for (int g = g_lo; g < g_hi; ++g) {
        const int gn = min(g + 1, g_hi - 1);
        A4_LOAD(gn, kn, vn);
#pragma unroll
        for (int i = 0; i < 4; ++i) {
            bool act = true;
            if (NA) { const int rsi = min(max(r0 + i - 4, 0), 24); act = (g >= rsi) && (g < rsi + 8); }
            if (act) {
                f32x4 s0 = mfma16(kc[0][0], q[i][0], (f32x4){0.f, 0.f, 0.f, 0.f}); s0 = mfma16(kc[0][1], q[i][1], s0);
                f32x4 s1 = mfma16(kc[1][0], q[i][0], (f32x4){0.f, 0.f, 0.f, 0.f}); s1 = mfma16(kc[1][1], q[i][1], s1);
                if (NA) {
                    const LAS float* bp = rpb + (h * 15 + (g - (r0 + i) + 7)) * 31;
#pragma unroll
                    for (int j = 0; j < 4; ++j) {
                        { const int kcx = kc0 + fq * 8 + j; const bool ok = (kcx >= qwin) && (kcx < qwin + 16); const float bv = bp[min(max(kcx - qcol + 15, 0), 30)];
                          s0[j] = ok ? s0[j] + bv : (-1.0e30f + bv * 0.f); }
                        { const int kcx = kc0 + fq * 8 + j + 4; const bool ok = (kcx >= qwin) && (kcx < qwin + 16); const float bv = bp[min(max(kcx - qcol + 15, 0), 30)];
                          s1[j] = ok ? s1[j] + bv : (-1.0e30f + bv * 0.f); }
                    }
                }
                float mloc = fmaxf(fmaxf(fmaxf(s0[0], s0[1]), fmaxf(s0[2], s0[3])), fmaxf(fmaxf(s1[0], s1[1]), fmaxf(s1[2], s1[3])));
                mloc = max4(mloc);
                const float mn = fmaxf(m[i], mloc), alpha = __expf(m[i] - mn); m[i] = mn;
                float p[8]; float ps = 0.f;
#pragma unroll
                for (int j = 0; j < 4; ++j) { p[j] = __expf(s0[j] - mn); p[4 + j] = __expf(s1[j] - mn); ps += p[j] + p[4 + j]; }
                l[i] = l[i] * alpha + ps;
                const bf16x8 pb = pack8(p);
#pragma unroll
                for (int et = 0; et < 4; ++et) { o[i][et] = o[i][et] * alpha; o[i][et] = mfma16(vc[et], pb, o[i][et]); }
            }
        }
#pragma unroll
        for (int T = 0; T < 2; ++T) { kc[T][0] = kn[T][0]; kc[T][1] = kn[T][1]; }
#pragma unroll
        for (int et = 0; et < 4; ++et) vc[et] = vn[et];
    }
#undef A4_LOAD
#pragma unroll
    for (int i = 0; i < 4; ++i) {
        const float inv = 1.f / red4(l[i]);
        bf16_t* op = brout + ((size_t)b * SEQ + qt0 + i * qstride + fr) * 256 + h * 64 + fq * 4;
#pragma unroll
        for (int et = 0; et < 4; ++et) st4bf(op + et * 16, o[i][et][0] * inv, o[i][et][1] * inv, o[i][et][2] * inv, o[i][et][3] * inv);
    }
}

__device__ __forceinline__ void pool_item(const unsigned char* ra, const bf16_t* poolwt  , const float* pscale, bf16_t* brout, int item, int lane) {
    const int fr = lane & 15, fq = lane >> 4;
    const int tt = item & 127, g = (item >> 7) & 3, b = item >> 9;
    const int t0 = tt * 16, t = t0 + fr, half = 1 << g;
    const int lo = max(t - half, 0), hi = min(t + half, SEQ);
    const float ic = 1.f / (float)(hi - lo);
    float wv[8];
#pragma unroll
    for (int i = 0; i < 8; ++i) { const int u = t0 - 8 + fq * 8 + i; wv[i] = ((u >= lo && u < hi) ? ic : 0.f) - ((u == t) ? 1.f : 0.f); }
    const bf16x8 band = pack8(wv);
    const int uc = min(max(t0 - 8 + fq * 8, 0), SEQ - 8);
    const bf16_t* base = (const bf16_t*)(ra + RA_PV) + ((size_t)(b * 4 + g) * 64 + fr) * SEQ + uc;
    f32x4 pl[4];
#pragma unroll
    for (int ct = 0; ct < 4; ++ct) pl[ct] = mfma16(ld16(base + (size_t)ct * 16 * SEQ), band, (f32x4){0.f, 0.f, 0.f, 0.f});
    float f0[8] = {pl[0][0], pl[0][1], pl[0][2], pl[0][3], pl[1][0], pl[1][1], pl[1][2], pl[1][3]};
    float f1[8] = {pl[2][0], pl[2][1], pl[2][2], pl[2][3], pl[3][0], pl[3][1], pl[3][2], pl[3][3]};
    const bf16x8 p0 = pack8_safe(f0), p1 = pack8_safe(f1);
    bf16_t* op = brout + ((size_t)b * SEQ + t) * 256 + g * 64 + fq * 4;
#pragma unroll
    for (int et = 0; et < 4; ++et) {
        const bf16_t* wp = poolwt + ((size_t)g * 64 + et * 16 + fr) * 64 + fq * 8;
        f32x4 o = mfma16(ld16(wp), p0, (f32x4){0.f, 0.f, 0.f, 0.f}); o = mfma16(ld16(wp + 32), p1, o);
        const f32x4 sv = *(const f32x4*)(pscale + g * 64 + et * 16 + fq * 4);
        st4bf(op + et * 16, o[0] * sv[0], o[1] * sv[1], o[2] * sv[2], o[3] * sv[3]);
    }
}

__device__ __forceinline__ void ret_item(const unsigned char* ra, const float* kvs, const float* rdf, const float* rdb, const float* rng  , bf16_t* brout,
                                         LAS unsigned char* lds, int item, int tid) {
    const int lane = tid & 63, w = __builtin_amdgcn_readfirstlane(tid >> 6), fr = lane & 15, fq = lane >> 4;
    const int n = item & 15, bh = item >> 4, h = bh & 3, b = bh >> 2;
    const float lgf = log2_sigmoid(rdf[h]), lgb = log2_sigmoid(rdb[h]);
    LAS bf16_t* SF = (LAS bf16_t*)lds; LAS bf16_t* SB = SF + 64 * 72;
    {
        const float cdF = exp2f(lgf * 128.f), cdB = exp2f(lgb * 128.f);
        const int idx = tid * 8, e = idx >> 6, d = idx & 63;
        float aF[8], aB[8];
#pragma unroll
        for (int i = 0; i < 8; ++i) { aF[i] = 0.f; aB[i] = 0.f; }
        const float* pF = kvs + ((size_t)(0 * 32 + bh) * 16) * 4096 + idx; const float* pB = kvs + ((size_t)(1 * 32 + bh) * 16) * 4096 + idx;
        f32x4 x0[15], x1[15];
#pragma unroll
        for (int j = 0; j < 15; ++j) { const float* p = (j < n) ? pF + (size_t)j * 4096 : pB + (size_t)(j + 1) * 4096; x0[j] = *(const f32x4*)p; x1[j] = *(const f32x4*)(p + 4); }
#pragma unroll
        for (int j = 0; j < 15; ++j) if (j < n) {
#pragma unroll
            for (int i = 0; i < 4; ++i) { aF[i] = cdF * aF[i] + x0[j][i]; aF[4 + i] = cdF * aF[4 + i] + x1[j][i]; } }
#pragma unroll
        for (int j = 14; j >= 0; --j) if (j >= n) {
#pragma unroll
            for (int i = 0; i < 4; ++i) { aB[i] = cdB * aB[i] + x0[j][i]; aB[4 + i] = cdB * aB[4 + i] + x1[j][i]; } }
        *(LAS bf16x8*)(SF + e * 72 + d) = pack8(aF); *(LAS bf16x8*)(SB + e * 72 + d) = pack8(aB);
    }
    const bf16_t* QR = (const bf16_t*)(ra + RA_QR) + (size_t)bh * SEQ * 64; const bf16_t* KR = (const bf16_t*)(ra + RA_KR) + (size_t)bh * SEQ * 64;
    const bf16_t* VRT = (const bf16_t*)(ra + RA_VRT) + (size_t)bh * 64 * SEQ; const bf16_t* GR = (const bf16_t*)(ra + RA_GR) + (size_t)bh * SEQ * 64;
    const int iq = w * 16 + fr, s = n * 128 + iq;
    const bf16_t* qp = QR + (size_t)s * 64 + fq * 8;
    const bf16x8 q0 = ld16(qp), q1 = ld16(qp + 32);
    const int krel = (fr >> 2) * 8 + (fr & 3);
    bf16x8 kf[4][2][2], vf[4][4];
#pragma unroll
    for (int g = 0; g < 4; ++g)
#pragma unroll
        for (int T = 0; T < 2; ++T) { const bf16_t* kp = KR + (size_t)(n * 128 + g * 32 + krel + 4 * T) * 64 + fq * 8; kf[g][T][0] = ld16(kp); kf[g][T][1] = ld16(kp + 32); }
#pragma unroll
    for (int g = 0; g < 4; ++g)
#pragma unroll
        for (int et = 0; et < 4; ++et) vf[g][et] = ld16(VRT + (size_t)(et * 16 + fr) * SEQ + n * 128 + g * 32 + fq * 8);
    __syncthreads();
    f32x4 o[4];
#pragma unroll
    for (int et = 0; et < 4; ++et) o[et] = (f32x4){0.f, 0.f, 0.f, 0.f};
#pragma unroll
    for (int g = 0; g < 4; ++g) {
        float f[8];
#pragma unroll
        for (int T = 0; T < 2; ++T) {
            f32x4 a = mfma16(kf[g][T][0], q0, (f32x4){0.f, 0.f, 0.f, 0.f}); a = mfma16(kf[g][T][1], q1, a);
#pragma unroll
            for (int j = 0; j < 4; ++j) { const int ke = g * 32 + fq * 8 + j + 4 * T; const int df = iq - ke;
                const float wgt = __builtin_amdgcn_exp2f(df >= 0 ? lgf * (float)df : lgb * (float)(-df));
                f[4 * T + j] = a[j] * wgt; }
        }
        const bf16x8 pb = pack8(f);
#pragma unroll
        for (int et = 0; et < 4; ++et) o[et] = mfma16(vf[g][et], pb, o[et]);
    }
    const float qdf = exp2f(lgf * (float)(iq + 1)), qdb = exp2f(lgb * (float)(128 - iq));
    float ssq = 0.f;
#pragma unroll
    for (int et = 0; et < 4; ++et) {
        const LAS bf16_t* sf = SF + (et * 16 + fr) * 72 + fq * 8; const LAS bf16_t* sb = SB + (et * 16 + fr) * 72 + fq * 8;
        f32x4 cf = mfma16(*(const LAS bf16x8*)sf, q0, (f32x4){0.f, 0.f, 0.f, 0.f}); cf = mfma16(*(const LAS bf16x8*)(sf + 32), q1, cf);
        f32x4 cb = mfma16(*(const LAS bf16x8*)sb, q0, (f32x4){0.f, 0.f, 0.f, 0.f}); cb = mfma16(*(const LAS bf16x8*)(sb + 32), q1, cb);
#pragma unroll
        for (int j = 0; j < 4; ++j) { o[et][j] += cf[j] * qdf + cb[j] * qdb; ssq += o[et][j] * o[et][j]; }
    }
    ssq = red4(ssq);
    const float rn = rsqrtf(ssq * (1.f / 64.f) + EPS);
    bf16_t* op = brout + ((size_t)b * SEQ + s) * 256 + h * 64 + fq * 4;
#pragma unroll
    for (int et = 0; et < 4; ++et) {
        const f32x4 gg = *(const f32x4*)(rng + h * 64 + et * 16 + fq * 4);
        const u32x2 gr = *(const u32x2*)(GR + (size_t)s * 64 + et * 16 + fq * 4);
        const float g0 = bflo(gr.x), g1 = bfhi(gr.x), g2 = bflo(gr.y), g3 = bfhi(gr.y);
        st4bf(op + et * 16, o[et][0] * rn * gg[0] * g0 * sigmoidf_(g0), o[et][1] * rn * gg[1] * g1 * sigmoidf_(g1),
              o[et][2] * rn * gg[2] * g2 * sigmoidf_(g2), o[et][3] * rn * gg[3] * g3 * sigmoidf_(g3));
    }
    __syncthreads();
}


__device__ __forceinline__ void ret2_item(const unsigned char* ra, const float* kvs, const float* rdf, const float* rdb, const float* rng  , bf16_t* brout,
                                          LAS unsigned char* lds, int pair, int tid) {
    const int lane = tid & 63, w = __builtin_amdgcn_readfirstlane(tid >> 6), fr = lane & 15, fq = lane >> 4;
    const int bh = pair >> 3, n0 = (pair & 7) * 2, h = bh & 3, b = bh >> 2;
    const float lgf = log2_sigmoid(rdf[h]), lgb = log2_sigmoid(rdb[h]);
    LAS bf16_t* SL = (LAS bf16_t*)lds;
    {
        const float cdF = exp2f(lgf * 128.f), cdB = exp2f(lgb * 128.f);
        const int idx = tid * 8, e = idx >> 6, d = idx & 63;
        const float* pF = kvs + ((size_t)(0 * 32 + bh) * 16) * 4096 + idx; const float* pB = kvs + ((size_t)(1 * 32 + bh) * 16) * 4096 + idx;
#pragma unroll 1
        for (int it = 0; it < 2; ++it) {
            const int n = n0 + it;
            float aF[8], aB[8];
#pragma unroll
            for (int i = 0; i < 8; ++i) { aF[i] = 0.f; aB[i] = 0.f; }
            f32x4 x0[15], x1[15];
#pragma unroll
            for (int j = 0; j < 15; ++j) { const float* p = (j < n) ? pF + (size_t)j * 4096 : pB + (size_t)(j + 1) * 4096; x0[j] = *(const f32x4*)p; x1[j] = *(const f32x4*)(p + 4); }
#pragma unroll
            for (int j = 0; j < 15; ++j) if (j < n) {
#pragma unroll
                for (int i = 0; i < 4; ++i) { aF[i] = cdF * aF[i] + x0[j][i]; aF[4 + i] = cdF * aF[4 + i] + x1[j][i]; } }
#pragma unroll
            for (int j = 14; j >= 0; --j) if (j >= n) {
#pragma unroll
                for (int i = 0; i < 4; ++i) { aB[i] = cdB * aB[i] + x0[j][i]; aB[4 + i] = cdB * aB[4 + i] + x1[j][i]; } }
            *(LAS bf16x8*)(SL + (it * 2 + 0) * 4608 + e * 72 + d) = pack8(aF); *(LAS bf16x8*)(SL + (it * 2 + 1) * 4608 + e * 72 + d) = pack8(aB);
        }
    }
    asm volatile("" ::: "memory");
    const int hb = w >> 2, wl = w & 3, n = n0 + hb;
    const bf16_t* QR = (const bf16_t*)(ra + RA_QR) + (size_t)bh * SEQ * 64; const bf16_t* KR = (const bf16_t*)(ra + RA_KR) + (size_t)bh * SEQ * 64;
    const bf16_t* VRT = (const bf16_t*)(ra + RA_VRT) + (size_t)bh * 64 * SEQ; const bf16_t* GR = (const bf16_t*)(ra + RA_GR) + (size_t)bh * SEQ * 64;
    const int krel = (fr >> 2) * 8 + (fr & 3);
    bf16x8 kf[4][2][2], vf[4][4];
#pragma unroll
    for (int g = 0; g < 4; ++g)
#pragma unroll
        for (int T = 0; T < 2; ++T) { const bf16_t* kp = KR + (size_t)(n * 128 + g * 32 + krel + 4 * T) * 64 + fq * 8; kf[g][T][0] = ld16(kp); kf[g][T][1] = ld16(kp + 32); }
#pragma unroll
    for (int g = 0; g < 4; ++g)
#pragma unroll
        for (int et = 0; et < 4; ++et) vf[g][et] = ld16(VRT + (size_t)(et * 16 + fr) * SEQ + n * 128 + g * 32 + fq * 8);
    __syncthreads();
    const LAS bf16_t* SF = SL + (hb * 2 + 0) * 4608; const LAS bf16_t* SB = SL + (hb * 2 + 1) * 4608;
#pragma unroll 1
    for (int t = 0; t < 2; ++t) {
        const int iq = (wl + 4 * t) * 16 + fr, s = n * 128 + iq;
        const bf16_t* qp = QR + (size_t)s * 64 + fq * 8;
        const bf16x8 qa = ld16(qp), qb = ld16(qp + 32);
        f32x4 o[4];
#pragma unroll
        for (int et = 0; et < 4; ++et) o[et] = (f32x4){0.f, 0.f, 0.f, 0.f};
#pragma unroll
        for (int g = 0; g < 4; ++g) {
            float f[8];
#pragma unroll
            for (int T = 0; T < 2; ++T) {
                f32x4 a = mfma16(kf[g][T][0], qa, (f32x4){0.f, 0.f, 0.f, 0.f}); a = mfma16(kf[g][T][1], qb, a);
#pragma unroll
                for (int j = 0; j < 4; ++j) { const int ke = g * 32 + fq * 8 + j + 4 * T; const int df = iq - ke;
                    const float wgt = __builtin_amdgcn_exp2f(df >= 0 ? lgf * (float)df : lgb * (float)(-df));
                    f[4 * T + j] = a[j] * wgt; }
            }
            const bf16x8 pb = pack8(f);
#pragma unroll
            for (int et = 0; et < 4; ++et) o[et] = mfma16(vf[g][et], pb, o[et]);
        }
        const float qdf = exp2f(lgf * (float)(iq + 1)), qdb = exp2f(lgb * (float)(128 - iq));
        float ssq = 0.f;
#pragma unroll
        for (int et = 0; et < 4; ++et) {
            const LAS bf16_t* sf = SF + (et * 16 + fr) * 72 + fq * 8; const LAS bf16_t* sb = SB + (et * 16 + fr) * 72 + fq * 8;
            f32x4 cf = mfma16(*(const LAS bf16x8*)sf, qa, (f32x4){0.f, 0.f, 0.f, 0.f}); cf = mfma16(*(const LAS bf16x8*)(sf + 32), qb, cf);
            f32x4 cb = mfma16(*(const LAS bf16x8*)sb, qa, (f32x4){0.f, 0.f, 0.f, 0.f}); cb = mfma16(*(const LAS bf16x8*)(sb + 32), qb, cb);
#pragma unroll
            for (int j = 0; j < 4; ++j) { o[et][j] += cf[j] * qdf + cb[j] * qdb; ssq += o[et][j] * o[et][j]; }
        }
        ssq = red4(ssq);
        const float rn = rsqrtf(ssq * (1.f / 64.f) + EPS);
        bf16_t* op = brout + ((size_t)b * SEQ + s) * 256 + h * 64 + fq * 4;
#pragma unroll
        for (int et = 0; et < 4; ++et) {
            const f32x4 gg = *(const f32x4*)(rng + h * 64 + et * 16 + fq * 4);
            const u32x2 gr = *(const u32x2*)(GR + (size_t)s * 64 + et * 16 + fq * 4);
            const float g0 = bflo(gr.x), g1 = bfhi(gr.x), g2 = bflo(gr.y), g3 = bfhi(gr.y);
            st4bf(op + et * 16, o[et][0] * rn * gg[0] * g0 * sigmoidf_(g0), o[et][1] * rn * gg[1] * g1 * sigmoidf_(g1),
                  o[et][2] * rn * gg[2] * g2 * sigmoidf_(g2), o[et][3] * rn * gg[3] * g3 * sigmoidf_(g3));
        }
    }
    __syncthreads();
}

#define XB_TMO      128
#define XB_XCNT(j)  (256  + 64 * (j))
#define XB_XSUB(j)  (1280 + 64 * (j))
#define XB_XGEN(j)  (2304 + 64 * (j))
#define XB_TOP      3328
#define XB_TOPGEN   3392
#define XCD_BAR_WORDS 3456
#define XB_SPIN_CAP (1u << 18)
__device__ __forceinline__ unsigned xb_ld(unsigned* p)              { return __hip_atomic_load(p, __ATOMIC_RELAXED, __HIP_MEMORY_SCOPE_AGENT); }
__device__ __forceinline__ unsigned xb_add(unsigned* p, unsigned v) { return __hip_atomic_fetch_add(p, v, __ATOMIC_RELAXED, __HIP_MEMORY_SCOPE_AGENT); }
__device__ __forceinline__ unsigned xb_xcc_id() { return (unsigned)__builtin_amdgcn_s_getreg((3 << 11) | 20) & 0xFu; }
#define XB_SPIN(cond, bar) do { unsigned _sp = 0; while (cond) { __builtin_amdgcn_s_sleep(1); \
    if ((++_sp & 255u) == 0u) { if (xb_ld(&(bar)[XB_TMO])) break; if (_sp > XB_SPIN_CAP) { atomicAdd(&(bar)[XB_TMO], 1u); break; } } } } while (0)
__device__ __forceinline__ void xcd_barrier_complete(unsigned* bar, unsigned x, unsigned& nloc, unsigned& nx) {
    const unsigned G = gridDim.x * gridDim.y * gridDim.z;
    unsigned sum, cnt, mine, sp = 0u;
    for (;;) {
        sum = 0u; cnt = 0u; mine = 0u;
#pragma unroll
        for (unsigned j = 0; j < 16; ++j) { const unsigned c = xb_ld(&bar[XB_XCNT(j)]); sum += c; cnt += (c > 0u) ? 1u : 0u; mine = (j == x) ? c : mine; }
        if (sum == G) break;
        __builtin_amdgcn_s_sleep(1);
        if ((++sp & 255u) == 0u) { if (xb_ld(&bar[XB_TMO])) break; if (sp > XB_SPIN_CAP) { atomicAdd(&bar[XB_TMO], 1u); break; } }
    }
    nloc = mine > 0u ? mine : 1u; nx = cnt > 0u ? cnt : 1u;
}
__device__ __forceinline__ void xcd_barrier(unsigned* bar, volatile LAS unsigned* st, bool leader) {
    asm volatile("s_waitcnt vmcnt(0)" ::: "memory");
    __syncthreads();
    if (leader) {
        const unsigned x = xb_xcc_id();
        __builtin_amdgcn_s_waitcnt(0);
        unsigned nloc = st[0], nx = st[1];
        if (nloc == 0u) { xcd_barrier_complete(bar, x, nloc, nx); st[0] = nloc; st[1] = nx; }
        const unsigned old = xb_add(&bar[XB_XSUB(x)], 1u);
        const unsigned gen = old / nloc;
        if (old + 1u == (gen + 1u) * nloc) {
            __builtin_amdgcn_fence(__ATOMIC_RELEASE, "agent");
            asm volatile("s_waitcnt vmcnt(0)" ::: "memory");
            const unsigned og = xb_add(&bar[XB_TOP], 1u);
            const unsigned tg = og / nx;
            if (og + 1u == (tg + 1u) * nx) xb_add(&bar[XB_TOPGEN], 1u);
            else XB_SPIN(xb_ld(&bar[XB_TOPGEN]) == tg, bar);
            __builtin_amdgcn_fence(__ATOMIC_ACQUIRE, "agent");
            xb_add(&bar[XB_XGEN(x)], 1u);
            asm volatile("s_waitcnt vmcnt(0)" ::: "memory");
        } else {
            XB_SPIN(xb_ld(&bar[XB_XGEN(x)]) == gen, bar);
            __builtin_amdgcn_fence(__ATOMIC_ACQUIRE, "agent");
            asm volatile("s_waitcnt vmcnt(0)" ::: "memory");
        }
    }
    __syncthreads();
}

__global__ void __launch_bounds__(512, 2) fwd_kernel(Args args) {
    extern __shared__ __attribute__((aligned(16))) unsigned char lds_raw[];
    LAS unsigned char* lds = (LAS unsigned char*)lds_raw;
    cg::grid_group grid = cg::this_grid();
    const int ph_lo = args.ph_lo, ph_hi = args.ph_hi;
    const int wave0 = __builtin_amdgcn_readfirstlane((int)threadIdx.x >> 6);
    if (threadIdx.x < 2) ((volatile LAS unsigned*)(lds + 131072))[threadIdx.x] = 0u;
    __syncthreads();
    bool census_posted = false;
    for (int pit = 2 * ph_lo; pit < 2 * ph_hi; ++pit) {
        const int ph = pit >> 1;
        const int l = (ph == 0) ? 0 : (ph - 1) / NPH_LAYER, k = (ph == 0) ? 0 : 1 + (ph - 1) % NPH_LAYER;
        if ((pit & 1) && !((REPM >> k) & 1)) continue;
#define PHASE_IDS int tid, G = gridDim.x, bid = blockIdx.x; asm volatile("v_mbcnt_lo_u32_b32 %0, -1, 0\n\tv_mbcnt_hi_u32_b32 %0, -1, %0" : "=v"(tid)); tid += wave0 * 64; asm volatile("" : "+v"(tid), "+s"(G), "+s"(bid)); \
        const int lane = tid & 63, wave = __builtin_amdgcn_readfirstlane(tid >> 6); const int gw = bid * 8 + wave, NGW = G * 8; (void)lane; (void)gw; (void)NGW;
        const __attribute__((address_space(4))) Args* ap = (const __attribute__((address_space(4))) Args*)__builtin_amdgcn_kernarg_segment_ptr();
        asm volatile("" : "+s"(ap));
#define AIN(i) (ap->in[i])
#define FRESH_TID(t) int t; asm volatile("v_mbcnt_lo_u32_b32 %0, -1, 0\n\tv_mbcnt_hi_u32_b32 %0, -1, %0" : "=v"(t)); t += wave0 * 64;
        unsigned char* ws = ap->ws;
        bf16_t* Wt = (bf16_t*)(ws + ((l & 1) ? WS_W1 : WS_W));
        bf16_t* XB0 = (bf16_t*)(ws + WS_XB0); bf16_t* BR = (bf16_t*)(ws + WS_BR); unsigned char* RA = ws + WS_RA; bf16_t* MEMB = (bf16_t*)(ws + WS_MEMB);
        float* SSQ0 = (float*)(ws + WS_SSQ0); float* SSQ1 = (float*)(ws + WS_SSQ1); float* SSQM = (float*)(ws + WS_SSQM); bf16_t* POOLW = (bf16_t*)(ws + WS_POOLW);
        bf16_t* XB1 = (bf16_t*)(RA + RA_XB1); bf16_t* UP = (bf16_t*)(RA + RA_UP); bf16_t* ACT = (bf16_t*)(RA + RA_ACT); bf16_t* MG = (bf16_t*)(ws + WS_MG);
        float* KVS = (float*)(RA + RA_KVS);
        float* out = ap->out;

        if (k == 0 && (PHM & 1)) { PHASE_IDS
            LAS unsigned* scr = (LAS unsigned*)(lds + wave * 9216);
            for (int it = gw; it < CI_TOTAL; it += NGW) cvt_layer_item(ap, 0, Wt, scr, it, lane);
            for (int m = gw; m < MTOK; m += NGW) row_to_bf16(AIN(I_X) + (size_t)m * DM, XB0 + (size_t)m * DM, SSQ0 + (size_t)m * 16, lane);
            for (int m = gw; m < BATCH * NMEM; m += NGW) row_to_bf16(AIN(I_MEM) + (size_t)m * DM, MEMB + (size_t)m * DM, SSQM + (size_t)m * 16, lane);
            for (int i = bid * 512 + tid; i < DEPTH * 4 * 64 * 64; i += G * 512) { const int kp = i & 63, e = (i >> 6) & 63, lg = i >> 12;
                const int c = (2 * (kp >> 5) + ((kp >> 2) & 1)) * 16 + ((kp >> 3) & 3) * 4 + (kp & 3);
                POOLW[i] = (bf16_t)(cvt_pk_bf16(AIN(I_POOLW)[(size_t)lg * 4096 + c * 64 + e], 0.f) & 0xffffu); }
            if (bid == 0 && tid < 64) ((unsigned*)(ws + WS_CTR))[tid] = 0u;
            if (bid == 0) for (int i = tid; i < XCD_BAR_WORDS; i += 512) ((unsigned*)(ws + WS_BAR))[i] = 0u;
            asm volatile("s_waitcnt vmcnt(0) lgkmcnt(0)" ::: "memory");
            __syncthreads();
        } else if (k == 1 && (PHM & 2)) { PHASE_IDS
            for (int sub = 0; sub < 2; ++sub) {
                pg8::Gemm g; pg8::StaticOrder S; EpiHead E;
                E.ap = ap; E.l = l;
                if (sub == 0) { g = pg8::Gemm{XB0, Wt + WO_IN, DM, DM, DM, 0, 0}; S.init(MTOK / 256, 9, 9, G, bid); E.memkv = 0; E.slen = SEQ; }
                else { g = pg8::Gemm{MEMB, Wt + WO_M, DM, DM, DM, 0, 0}; S.init(BATCH, 2, 2, G, (bid + G - 64 % G) % G); E.memkv = 1; E.slen = NMEM; }
                FRESH_TID(t1)
                pg8::gemm_phase<EpiHead, true, pg8::StaticOrder>(lds, g, S, E, t1);
            }
            if (l + 1 < DEPTH) {
                FRESH_TID(t3) const int lane = t3 & 63;
                LAS unsigned* scr = (LAS unsigned*)(lds + wave0 * 9216);
                bf16_t* Wn = (bf16_t*)(ws + (((l + 1) & 1) ? WS_W1 : WS_W));
                unsigned* ctr = (unsigned*)(ws + WS_CTR) + (l + 1);
                for (;;) {
                    unsigned it = 0; if (lane == 0) it = atomicAdd(ctr, 1u);
                    it = (unsigned)__builtin_amdgcn_readfirstlane((int)it);
                    if (it >= (unsigned)CI_TOTAL) break;
                    cvt_layer_item(ap, l + 1, Wn, scr, (int)it, lane);
                }
                asm volatile("s_waitcnt vmcnt(0) lgkmcnt(0)" ::: "memory");
                __syncthreads();
            }
        } else if (k == 2 && (PHM & 4)) { PHASE_IDS
            const float* rdf = AIN(I_RDF) + l * 4; const float* rdb = AIN(I_RDB) + l * 4;
            LAS float* rpb = (LAS float*)lds;
            for (int i = tid; i < 4 * 15 * 31; i += 512) rpb[i] = AIN(I_RPB)[(size_t)l * 4 * 15 * 31 + i];
            __syncthreads();
            constexpr int N_KV = 1024, N_NA = 1024, N_MA = 1024, N_PL = 4096;
            const int gwr = (gw + NGW - (N_KV % NGW)) % NGW;
            if (ITM & 1) for (int it = gw; it < N_KV; it += NGW) kv_item(RA, KVS, rdf, rdb, it, lane);
            if (ITM & 2) for (int it = gwr; it < N_NA; it += NGW) attn4_item<true>(RA, rpb, BR + (size_t)2 * MTOK * 256, it, lane);
            if (ITM & 4) for (int it = gw; it < N_MA; it += NGW) attn4_item<false>(RA, rpb, BR + (size_t)3 * MTOK * 256, it, lane);
            if (NGW == 2048) {
                const int np = 2, p0 = gw * 2;
                for (int k2 = 0; k2 < np; ++k2) pool_item(RA, POOLW + (size_t)l * 4 * 4096, AIN(I_POOLS) + l * 256, BR + (size_t)1 * MTOK * 256, p0 + k2, lane);
            } else
                for (int it = gwr; it < N_PL; it += NGW) pool_item(RA, POOLW + (size_t)l * 4 * 4096, AIN(I_POOLS) + l * 256, BR + (size_t)1 * MTOK * 256, it, lane);
            __syncthreads();
        } else if (k == 3 && (PHM & 8)) { PHASE_IDS
            for (int it = bid; it < 256; it += G)
                ret2_item(RA, KVS, AIN(I_RDF) + l * 4, AIN(I_RDB) + l * 4, AIN(I_RNG) + l * 256, BR, lds, it, tid);
        } else if (k == 4 && (PHM & 16)) { PHASE_IDS
            const int vcu = (G % 8 == 0) ? (bid % 8) * (G / 8) + bid / 8 : bid;
            for (int su = vcu; su < 256; su += G) {
                const int pm = su >> 2, pd = su & 3;
                { pg8::Gemm g{BR, Wt + WO_B, 256, 256, 256, (unsigned)MTOK * 256u, (unsigned)DM * 256u}; pg8::BlockOrder S{pm, pd, 0, 0, 1, 4};
                  EpiUp E{UP}; FRESH_TID(t1)
                  pg8::gemm_phase<EpiUp, true, pg8::BlockOrder>(lds, g, S, E, t1); }
                { pg8::Gemm g{XB0, Wt + WO_G, DM, DM, DM, 0, 0}; pg8::BlockOrder S{pm, 4 * pd, 1, 0, 0, 4};
                  EpiGate E{SSQ0, UP, MG}; FRESH_TID(t2)
                  pg8::gemm_phase<EpiGate, true, pg8::BlockOrder>(lds, g, S, E, t2); }
            }
        } else if ((k == 5 || k == 7) && (PHM & 64)) { PHASE_IDS
            pg8::Gemm g; EpiResid E;
            if (k == 5) { g = pg8::Gemm{MG, Wt + WO_O, DM, DM, DM, 0, 0}; E = EpiResid{l == 0 ? AIN(I_X) : out, out, XB1, SSQ1, 1}; }
            else { g = pg8::Gemm{ACT, Wt + WO_FO, FFH, FFH, FFH, 0, 0}; E = EpiResid{out, out, XB0, SSQ0, l != DEPTH - 1}; }
            pg8::StaticOrder S; S.init(MTOK / 256, 4, 4, G, bid);
            pg8::gemm_phase<EpiResid, true, pg8::StaticOrder>(lds, g, S, E, tid);
        } else if (k == 6 && (PHM & 128)) { PHASE_IDS
            pg8::Gemm g{XB1, Wt + WO_FI, DM, DM, DM, 0, 0}; pg8::StaticOrder S; S.init(MTOK / 256, 22, 22, G, bid);
            EpiSwiglu E{SSQ1, ACT};
            pg8::gemm_phase<EpiSwiglu, true, pg8::StaticOrder>(lds, g, S, E, tid);
        }
        asm volatile("s_waitcnt vmcnt(0) lgkmcnt(0)" ::: "memory");
        if (pit + 1 < 2 * ph_hi) {
            int ln; asm volatile("v_mbcnt_lo_u32_b32 %0, -1, 0\n\tv_mbcnt_hi_u32_b32 %0, -1, %0" : "=v"(ln));
            const bool leader = (wave0 == 0) && (ln == 0);
            unsigned* bar = (unsigned*)(ap->ws + WS_BAR);
            if (!census_posted) {
                grid.sync();
                if (leader) (void)xb_add(&bar[XB_XCNT(xb_xcc_id())], 1u);
                census_posted = true;
            } else xcd_barrier(bar, (volatile LAS unsigned*)(lds + 131072), leader);
        }
    }
}

extern "C" void kernel_launch(void* const* d_in, const int* in_sizes, int n_in, void* d_out, int out_size, void* d_ws, size_t ws_size, hipStream_t stream) {
    static int grid = 0;
    if (grid == 0) {
        if (n_in != 22 || out_size != MTOK * DM || ws_size < WS_END) { fprintf(stderr, "kernel_launch: unexpected shapes (n_in %d, out %d, ws %zu)\n", n_in, out_size, ws_size); grid = -1; return; }
        int dev = 0, cus = 0, per_cu = 0;
        hipGetDevice(&dev);
        hipDeviceGetAttribute(&cus, hipDeviceAttributeMultiprocessorCount, dev);
        hipFuncSetAttribute((const void*)fwd_kernel, hipFuncAttributeMaxDynamicSharedMemorySize, LDS_BYTES);
        hipOccupancyMaxActiveBlocksPerMultiprocessor(&per_cu, (const void*)fwd_kernel, 512, LDS_BYTES);
        if (per_cu < 1) { fprintf(stderr, "kernel_launch: occupancy query says %d blocks per CU\n", per_cu); per_cu = 1; }
        grid = cus;
        (void)hipGetLastError();
    }
    if (grid < 0) return;
    Args a{};
    for (int i = 0; i < 22; ++i) a.in[i] = (const float*)d_in[i];
    a.out = (float*)d_out; a.ws = (unsigned char*)d_ws;
#if MK_SINGLE
    a.ph_lo = 0; a.ph_hi = NPHASES;
    void* kargs[] = {&a};
    hipError_t e = hipLaunchCooperativeKernel((const void*)fwd_kernel, dim3(grid), dim3(512), kargs, LDS_BYTES, stream);
    if (e != hipSuccess) fprintf(stderr, "cooperative launch failed: %s (grid %d)\n", hipGetErrorString(e), grid);
#else
    for (int ph = 0; ph < NPHASES; ++ph) { a.ph_lo = ph; a.ph_hi = ph + 1; hipLaunchKernelGGL(fwd_kernel, dim3(grid), dim3(512), LDS_BYTES, stream, a); }
#endif
}
```

```cpp
#include <hip/hip_runtime.h>
#include <hip/hip_cooperative_groups.h>
#include <cstdio>
#include <cstdint>
namespace cg = cooperative_groups;

#ifndef REPM
#define REPM 0
#endif
#ifndef ITM
#define ITM 15
#endif
#ifndef PHM
#define PHM 255
#endif
#ifndef MK_SINGLE
#define MK_SINGLE 1
#endif

#define LAS __attribute__((address_space(3)))
typedef unsigned short bf16_t;
typedef short bf16x8 __attribute__((ext_vector_type(8)));
typedef float f32x4 __attribute__((ext_vector_type(4)));
typedef unsigned u32x4 __attribute__((ext_vector_type(4)));
typedef unsigned u32x2 __attribute__((ext_vector_type(2)));

constexpr int DM = 1024, BATCH = 8, SEQ = 2048, DEPTH = 4, MTOK = BATCH * SEQ, NMEM = 256, INW = 2304, FFH = 2816;
constexpr float EPS = 1e-6f;
constexpr int NPH_LAYER = 7, NPHASES = 1 + DEPTH * NPH_LAYER;

constexpr size_t MiB = 1u << 20;
constexpr size_t WS_W = 0, WS_XB0 = 36 * MiB, WS_BR = 68 * MiB, WS_RA = 100 * MiB, WS_MEMB = 228 * MiB, WS_SSQ0 = 232 * MiB, WS_SSQ1 = 233 * MiB,
                 WS_SSQM = 234 * MiB, WS_POOLW = 235 * MiB, WS_CTR = 235 * MiB + 512 * 1024, WS_MG = 236 * MiB, WS_W1 = 268 * MiB, WS_END = 304 * MiB;
constexpr size_t WO_IN = 0, WO_G = 2359296, WO_B = 6553600, WO_O = 7602176, WO_FI = 8650752, WO_FO = 14417920, WO_M = 17301504;
constexpr size_t RA_SLOT = 8 * MiB;
constexpr size_t RA_QR = 0, RA_KR = 8 * MiB, RA_VRT = 16 * MiB, RA_GR = 24 * MiB, RA_PV = 32 * MiB, RA_NQ = 40 * MiB, RA_NK = 48 * MiB, RA_NVT = 56 * MiB,
                 RA_MQ = 64 * MiB, RA_KRT = 72 * MiB, RA_MK = 80 * MiB, RA_MVT = 81 * MiB, RA_KVS = 82 * MiB;
constexpr size_t RA_UP = 0, RA_ACT = 0, RA_XB1 = 96 * MiB;
constexpr int LDS_BYTES = 131072 + 64;
constexpr size_t WS_BAR = 235 * MiB + 768 * 1024;

__device__ __forceinline__ unsigned cvt_pk_bf16(float lo, float hi) { unsigned r; asm("v_cvt_pk_bf16_f32 %0, %1, %2" : "=v"(r) : "v"(lo), "v"(hi)); return r; }
typedef float f32x2_t __attribute__((ext_vector_type(2)));
typedef __bf16 bf16x2_t __attribute__((ext_vector_type(2)));
__device__ __forceinline__ unsigned cvt_pk_bf16_safe(float lo, float hi) { f32x2_t v = {lo, hi}; bf16x2_t b = __builtin_convertvector(v, bf16x2_t); return __builtin_bit_cast(unsigned, b); }
__device__ __forceinline__ float bf2f(unsigned short u) { return __builtin_bit_cast(float, (unsigned)u << 16); }
__device__ __forceinline__ float bflo(unsigned u) { return __builtin_bit_cast(float, u << 16); }
__device__ __forceinline__ float bfhi(unsigned u) { return __builtin_bit_cast(float, u & 0xffff0000u); }
__device__ __forceinline__ bf16x8 ld16(const bf16_t* p) { return *(const bf16x8*)p; }
__device__ __forceinline__ f32x4 mfma16(bf16x8 a, bf16x8 b, f32x4 c) { return __builtin_amdgcn_mfma_f32_16x16x32_bf16(a, b, c, 0, 0, 0); }
__device__ __forceinline__ float red4(float v) { v += __shfl_xor(v, 16); v += __shfl_xor(v, 32); return v; }
__device__ __forceinline__ float max4(float v) { v = fmaxf(v, __shfl_xor(v, 16)); v = fmaxf(v, __shfl_xor(v, 32)); return v; }
__device__ __forceinline__ float wave_sum(float v) {
#pragma unroll
    for (int o = 1; o < 64; o <<= 1) v += __shfl_xor(v, o);
    return v;
}
__device__ __forceinline__ bf16x8 pack8(const float* f) {
    u32x4 w; w.x = cvt_pk_bf16(f[0], f[1]); w.y = cvt_pk_bf16(f[2], f[3]); w.z = cvt_pk_bf16(f[4], f[5]); w.w = cvt_pk_bf16(f[6], f[7]);
    return __builtin_bit_cast(bf16x8, w);
}
__device__ __forceinline__ bf16x8 pack8_safe(const float* f) {
    u32x4 w; w.x = cvt_pk_bf16_safe(f[0], f[1]); w.y = cvt_pk_bf16_safe(f[2], f[3]); w.z = cvt_pk_bf16_safe(f[4], f[5]); w.w = cvt_pk_bf16_safe(f[6], f[7]);
    return __builtin_bit_cast(bf16x8, w);
}
__device__ __forceinline__ void unpack8(bf16x8 v, float* f) {
    u32x4 w = __builtin_bit_cast(u32x4, v);
    f[0] = bflo(w.x); f[1] = bfhi(w.x); f[2] = bflo(w.y); f[3] = bfhi(w.y); f[4] = bflo(w.z); f[5] = bfhi(w.z); f[6] = bflo(w.w); f[7] = bfhi(w.w);
}
__device__ __forceinline__ void st4bf(bf16_t* p, float a, float b, float c, float d) { u32x2 w; w.x = cvt_pk_bf16(a, b); w.y = cvt_pk_bf16(c, d); *(u32x2*)p = w; }
__device__ __forceinline__ void st4bf_safe(bf16_t* p, float a, float b, float c, float d) { u32x2 w; w.x = cvt_pk_bf16_safe(a, b); w.y = cvt_pk_bf16_safe(c, d); *(u32x2*)p = w; }
__device__ __forceinline__ float sigmoidf_(float x) { return __builtin_amdgcn_rcpf(1.f + __expf(-x)); }

namespace pg8 {
constexpr int BM = 256, BK = 64, HALF = 128, HTB = HALF * BK * 2, NXCD = 8, WGM = 8;
__host__ __device__ __forceinline__ int lds_byte(int r, int c) { const int st = (r >> 4) * 2 + (c >> 5), rr = r & 15, cc = c & 31, ob = rr * 64 + cc * 2; return st * 1024 + (ob ^ (((ob >> 9) & 1) << 5)); }
__host__ __device__ __forceinline__ void stage_rc(int b, int& R, int& C) { const int st = b / 1024, sb = b % 1024, swz = sb ^ (((sb >> 9) & 1) << 5); R = (st >> 1) * 16 + swz / 64; C = (st & 1) * 32 + (swz % 64) / 2; }

struct Unit { int pm, pn, g; };
struct Gemm { const bf16_t* A; const bf16_t* Bt; int lda, ldb, K; unsigned gA, gB; };

struct StaticOrder {
    int nM, nN, nNg, nwg, G, c;
    __device__ void init(int nM_, int nNtot, int nNg_, int G_, int c_) { nM = nM_; nN = nNtot; nNg = nNg_; nwg = nM * nN; G = G_; c = c_; }
    __device__ bool next(int i, Unit& u) const {
        const int L = i * G + c; if (L >= nwg) return false;
        int wgid = L; { const int q = nwg / NXCD, r = nwg % NXCD, xcd = wgid % NXCD, off = wgid / NXCD; wgid = (xcd < r ? xcd * (q + 1) : r * (q + 1) + (xcd - r) * q) + off; }
        const int nig = WGM * nN, gid = wgid / nig, fm = gid * WGM, gsz = (nM - fm) < WGM ? (nM - fm) : WGM;
        u.pm = fm + ((wgid % nig) % gsz); const int pnt = (wgid % nig) / gsz; u.g = pnt / nNg; u.pn = pnt % nNg; return true;
    }
};

struct BlockOrder {
    int pm, pn0, pnstep, g0, gstep, n;
    __device__ bool next(int i, Unit& u) const { if (i >= n) return false; u.pm = pm; u.pn = pn0 + i * pnstep; u.g = g0 + i * gstep; return true; }
};
template <class Epi, bool ALIGN_EPI, class Sched>
__device__ __forceinline__ void gemm_phase(LAS unsigned char* lds, const Gemm g, const Sched& S, const Epi& E, int tid) {
    asm volatile("" : "+v"(tid));
    const int wid = __builtin_amdgcn_readfirstlane(tid >> 6), lane = tid & 63, wr = wid >> 2, wc = wid & 3, fr = lane & 15, fq = lane >> 4;
    const int K = g.K, nt = K / BK;
    unsigned voff[2];
#pragma unroll
    for (int i = 0; i < 2; ++i) { int R, C; stage_rc(tid * 16 + i * 8192, R, C); voff[i] = (unsigned)(R * g.lda + C) * 2u; }
    const unsigned kstep = (unsigned)(BK * 2);
    const unsigned hstepA = (unsigned)HALF * g.lda * 2;
#define hstepB hstepA
    const unsigned ldsw = (unsigned)wid * 1024u;
    const int aoff = lds_byte(wr * 64 + fr, fq * 8), boff = lds_byte(wc * 32 + fr, fq * 8);
#define PG8_SA(b, h) (((b) * 2 + (h)) * HTB)
#define PG8_SB(b, h) ((4 + (b) * 2 + (h)) * HTB)
#define voffA g.A
#define voffB g.Bt
#define PG8_STAGE(bufoff, gbase, mat) do { _Pragma("unroll") for (int _i = 0; _i < 2; ++_i) \
        __builtin_amdgcn_global_load_lds((const unsigned*)((const char*)(mat) + (size_t)(gbase) + voff[_i]), (LAS unsigned*)(lds + (bufoff) + ldsw + _i * 8192), 16, 0, 0); } while (0)
#define PG8_LDA(dst, b, h) do { _Pragma("unroll") for (int m = 0; m < 4; ++m) _Pragma("unroll") for (int k = 0; k < 2; ++k) dst[m][k] = *(const LAS bf16x8*)(lds + PG8_SA(b, h) + aoff + m * 2048 + k * 1024); } while (0)
#define PG8_LDB(dst, b, h) do { _Pragma("unroll") for (int n = 0; n < 2; ++n) _Pragma("unroll") for (int k = 0; k < 2; ++k) dst[n][k] = *(const LAS bf16x8*)(lds + PG8_SB(b, h) + boff + n * 2048 + k * 1024); } while (0)
#define PG8_MMA(ai, bj, At, Bt) do { __builtin_amdgcn_s_setprio(1); _Pragma("unroll") for (int m = 0; m < 4; ++m) _Pragma("unroll") for (int n = 0; n < 2; ++n) _Pragma("unroll") for (int k = 0; k < 2; ++k) \
        acc[ai][bj][m][n] = __builtin_amdgcn_mfma_f32_16x16x32_bf16(Bt[n][k], At[m][k], acc[ai][bj][m][n], 0, 0, 0); __builtin_amdgcn_s_setprio(0); } while (0)
#define PG8_WAIT_V(n) asm volatile("s_waitcnt vmcnt(" #n ")" ::: "memory")
#define PG8_WAIT_L(n) asm volatile("s_waitcnt lgkmcnt(" #n ")" ::: "memory")
#define PG8_BAR __builtin_amdgcn_s_barrier()
#define PG8_SCHED __builtin_amdgcn_sched_barrier(0)
#define PG8_ABASE(u) (((unsigned)(u).g * (unsigned)g.gA + (unsigned)(u).pm * BM * g.lda) * 2u)
#define PG8_BBASE(u) (((unsigned)(u).g * (unsigned)g.gB + (unsigned)(u).pn * BM * g.ldb) * 2u)
    Unit cur, nxt; int ui = 0;
    if (!S.next(0, cur)) return;
    f32x4 acc[2][2][4][2];
#pragma unroll
    for (int a = 0; a < 2; ++a)
#pragma unroll
        for (int b = 0; b < 2; ++b)
#pragma unroll
            for (int m = 0; m < 4; ++m)
#pragma unroll
                for (int n = 0; n < 2; ++n) acc[a][b][m][n] = (f32x4){0.f, 0.f, 0.f, 0.f};
    bf16x8 At[4][2], B0[2][2], B1[2][2];
    unsigned cA = PG8_ABASE(cur), cB = PG8_BBASE(cur);
    PG8_STAGE(PG8_SB(0, 0), cB, voffB); PG8_STAGE(PG8_SB(0, 1), cB + hstepB, voffB); PG8_STAGE(PG8_SA(0, 0), cA, voffA); PG8_STAGE(PG8_SA(0, 1), cA + hstepA, voffA);
    if (wr == 1) PG8_BAR;
    PG8_WAIT_V(2); PG8_BAR;
    PG8_STAGE(PG8_SB(1, 0), cB + kstep, voffB); PG8_STAGE(PG8_SA(1, 0), cA + kstep, voffA); PG8_STAGE(PG8_SB(1, 1), cB + hstepB + kstep, voffB);
    PG8_WAIT_V(6); PG8_BAR;
    for (;;) {
        const bool has_next = S.next(ui + 1, nxt);
        const unsigned nA = has_next ? PG8_ABASE(nxt) : cA, nB = has_next ? PG8_BBASE(nxt) : cB;
        for (int t = 0; t < nt; t += 2) {
            const bool last = (t == nt - 2);
            const unsigned a1 = cA + (unsigned)(t + 1) * kstep;
            const unsigned a2 = last ? nA : cA + (unsigned)(t + 2) * kstep, b2 = last ? nB : cB + (unsigned)(t + 2) * kstep;
            const unsigned a3 = a2 + kstep, b3 = b2 + kstep;
            PG8_LDB(B0, 0, 0); PG8_LDB(B1, 0, 1); PG8_SCHED; PG8_LDA(At, 0, 0); PG8_STAGE(PG8_SA(1, 1), a1 + hstepA, voffA);
            PG8_WAIT_V(8); PG8_WAIT_L(0); PG8_BAR; PG8_MMA(0, 0, At, B0); PG8_MMA(0, 1, At, B1); PG8_BAR; PG8_SCHED;
            PG8_LDA(At, 0, 1); PG8_STAGE(PG8_SB(0, 0), b2, voffB); PG8_STAGE(PG8_SB(0, 1), b2 + hstepB, voffB); PG8_STAGE(PG8_SA(0, 0), a2, voffA);
            PG8_WAIT_V(8); PG8_WAIT_L(0); PG8_BAR; PG8_MMA(1, 0, At, B0); PG8_MMA(1, 1, At, B1); PG8_BAR; PG8_SCHED;
            PG8_LDB(B0, 1, 0); PG8_LDB(B1, 1, 1); PG8_SCHED; PG8_LDA(At, 1, 0); PG8_STAGE(PG8_SA(0, 1), a2 + hstepA, voffA);
            PG8_WAIT_V(8); PG8_WAIT_L(0); PG8_BAR; PG8_MMA(0, 0, At, B0); PG8_MMA(0, 1, At, B1); PG8_BAR; PG8_SCHED;
            PG8_LDA(At, 1, 1); PG8_STAGE(PG8_SB(1, 0), b3, voffB); PG8_STAGE(PG8_SB(1, 1), b3 + hstepB, voffB); PG8_STAGE(PG8_SA(1, 0), a3, voffA);
            PG8_WAIT_V(8); PG8_WAIT_L(0); PG8_BAR; PG8_MMA(1, 0, At, B0); PG8_MMA(1, 1, At, B1); PG8_BAR; PG8_SCHED;
        }
        if constexpr (ALIGN_EPI) { if (wr == 0) PG8_BAR; }
        { int frl = fr, fql = fq; asm volatile("" : "+v"(frl), "+v"(fql)); E(acc, cur, wr, wc, frl, fql); }
        if (!has_next) break;
#pragma unroll
        for (int a = 0; a < 2; ++a)
#pragma unroll
            for (int b = 0; b < 2; ++b)
#pragma unroll
                for (int m = 0; m < 4; ++m)
#pragma unroll
                    for (int n = 0; n < 2; ++n) acc[a][b][m][n] = (f32x4){0.f, 0.f, 0.f, 0.f};
        cur = nxt; cA = nA; cB = nB; ++ui;
        if constexpr (ALIGN_EPI) { if (wr == 1) PG8_BAR; }
    }
    PG8_WAIT_V(0);
    if constexpr (!ALIGN_EPI) { if (wr == 0) PG8_BAR; }
    PG8_BAR;
#undef PG8_SA
#undef PG8_SB
#undef PG8_STAGE
#undef PG8_LDA
#undef PG8_LDB
#undef PG8_MMA
#undef PG8_WAIT_V
#undef PG8_WAIT_L
#undef PG8_BAR
#undef PG8_SCHED
#undef PG8_ABASE
#undef voffA
#undef voffB
#undef hstepB
#undef PG8_BBASE
}
}
struct Args { const float* in[22]; float* out; unsigned char* ws; int ph_lo, ph_hi; };
enum { I_X = 0, I_MEM, I_NMIX, I_NMEM, I_WIN, I_WGATE, I_RDF, I_RDB, I_RNG, I_POOLW, I_POOLS, I_NAQ, I_NAK, I_RPB, I_MQG, I_MKG, I_WMKV, I_WBR, I_WOUT, I_NFFN, I_WFI, I_WFO };

typedef f32x4 Acc[2][2][4][2];

__device__ __forceinline__ void row_rinv(const float* ssq, int row0, int fq, float (&rinv)[2][4]) {
#pragma unroll
    for (int ai = 0; ai < 2; ++ai)
#pragma unroll
        for (int m = 0; m < 4; ++m) {
            const f32x4 v = *(const f32x4*)(ssq + (size_t)(row0 + ai * 128 + m * 16) * 16 + fq * 4);
            const float s = red4((v.x + v.y) + (v.z + v.w));
            rinv[ai][m] = rsqrtf(s * (1.f / DM) + EPS);
        }
}

struct EpiHead {
    const __attribute__((address_space(4))) Args* ap; int l; int memkv; int slen;
    __device__ __forceinline__ void operator()(const Acc& acc, const pg8::Unit& u, int wr, int wc, int fr, int fq) const {
        unsigned char* ra = ap->ws + WS_RA;
        float rinv[2][4]; row_rinv((const float*)(ap->ws + (memkv ? WS_SSQM : WS_SSQ0)), u.pm * 256 + wr * 64 + fr, fq, rinv);
        const int tpb = slen >> 8;
        const int b = u.pm / tpb, s0 = (u.pm % tpb) * 256 + wr * 64 + fr, bh = b * 4 + wc;
        int mode; float scale = 1.f; const float* gv = nullptr; bf16_t* dst = nullptr; bf16_t* dstT = nullptr;
        const int pn = u.pn;
        if (memkv) {
            if (pn == 0) { mode = 3; gv = ap->in[I_MKG] + l * 64; dst = (bf16_t*)(ra + RA_MK); } else { mode = 2; dstT = (bf16_t*)(ra + RA_MVT); }
        } else {
            dst = (bf16_t*)(ra + (size_t)pn * RA_SLOT);
            if (pn == 0) { mode = 1; scale = 0.125f; }
            else if (pn == 1) { mode = 1; dstT = (bf16_t*)(ra + RA_KRT); }
            else if (pn == 2 || pn == 7 || pn == 4) { mode = 2; dstT = dst; }
            else if (pn == 3) { mode = 0; }
            else { mode = 3; gv = ap->in[(pn == 5) ? I_NAQ : (pn == 6 ? I_NAK : I_MQG)] + l * 64; scale = (pn == 6) ? 1.f : 0.125f; }
        }
#pragma unroll
        for (int ai = 0; ai < 2; ++ai)
#pragma unroll
            for (int m = 0; m < 4; ++m) {
                const int s = s0 + ai * 128 + m * 16;
                float v[2][2][4];
#pragma unroll
                for (int bj = 0; bj < 2; ++bj)
#pragma unroll
                    for (int n = 0; n < 2; ++n)
#pragma unroll
                        for (int j = 0; j < 4; ++j) v[bj][n][j] = acc[ai][bj][m][n][j] * rinv[ai][m];
                if (mode == 1) {
#pragma unroll
                    for (int n = 0; n < 2; ++n)
#pragma unroll
                        for (int j = 0; j < 4; ++j) {
                            const int i = 16 * n + 4 * fq + j;
                            const float inv = exp2f(-(float)i * (13.287712379549449f / 32.f));
                            const float fr_ = __builtin_amdgcn_fractf((float)s * inv * 0.15915494309189535f);
                            const float sn = __builtin_amdgcn_sinf(fr_), cs = __builtin_amdgcn_cosf(fr_);
                            const float t1 = v[0][n][j], t2 = v[1][n][j];
                            v[0][n][j] = (t1 * cs - t2 * sn) * scale; v[1][n][j] = (t1 * sn + t2 * cs) * scale;
                        }
                } else if (mode == 3) {
                    float q = 0.f;
#pragma unroll
                    for (int bj = 0; bj < 2; ++bj)
#pragma unroll
                        for (int n = 0; n < 2; ++n)
#pragma unroll
                            for (int j = 0; j < 4; ++j) q += v[bj][n][j] * v[bj][n][j];
                    q = red4(q);
                    const float rn = rsqrtf(q * (1.f / 64.f) + EPS) * scale;
#pragma unroll
                    for (int bj = 0; bj < 2; ++bj)
#pragma unroll
                        for (int n = 0; n < 2; ++n) {
                            const f32x4 gg = *(const f32x4*)(gv + 32 * bj + 16 * n + 4 * fq);
#pragma unroll
                            for (int j = 0; j < 4; ++j) v[bj][n][j] *= rn * gg[j];
                        }
                }
                if (mode != 2) {
                    bf16_t* p = dst + ((size_t)bh * slen + s) * 64 + 4 * fq;
#pragma unroll
                    for (int bj = 0; bj < 2; ++bj)
#pragma unroll
                        for (int n = 0; n < 2; ++n) st4bf(p + 32 * bj + 16 * n, v[bj][n][0], v[bj][n][1], v[bj][n][2], v[bj][n][3]);
                }
                if (dstT) {
                    bf16_t* p = dstT + ((size_t)bh * 64 + 4 * fq) * slen + s;
#pragma unroll
                    for (int bj = 0; bj < 2; ++bj)
#pragma unroll
                        for (int n = 0; n < 2; ++n)
#pragma unroll
                            for (int j = 0; j < 4; ++j) p[(size_t)(32 * bj + 16 * n + j) * slen] = (bf16_t)(cvt_pk_bf16(v[bj][n][j], 0.f) & 0xffffu);
                }
            }
    }
};

__device__ __forceinline__ size_t up_slot(int su, int n, int ai, int m, int bj, int nn, int wave, int lane) {
    return ((((((((size_t)su * 4 + n) * 2 + ai) * 4 + m) * 2 + bj) * 2 + nn) * 8 + wave) * 64 + lane) * 4;
}
struct EpiUp {
    bf16_t* up;
    __device__ __forceinline__ void operator()(const Acc& acc, const pg8::Unit& u, int wr, int wc, int fr, int fq) const {
        const int su = u.pm * 4 + u.pn, wave = wr * 4 + wc, lane = fq * 16 + fr;
#pragma unroll
        for (int ai = 0; ai < 2; ++ai)
#pragma unroll
            for (int m = 0; m < 4; ++m)
#pragma unroll
                for (int bj = 0; bj < 2; ++bj)
#pragma unroll
                    for (int n = 0; n < 2; ++n) { const f32x4 a = acc[ai][bj][m][n]; st4bf_safe(up + up_slot(su, u.g, ai, m, bj, n, wave, lane), a[0], a[1], a[2], a[3]); }
    }
};

struct EpiGate {
    const float* ssq; const bf16_t* up; bf16_t* mg;
    __device__ __forceinline__ void operator()(const Acc& acc, const pg8::Unit& u, int wr, int wc, int fr, int fq) const {
        float rinv[2][4]; const int row0 = u.pm * 256 + wr * 64 + fr; row_rinv(ssq, row0, fq, rinv);
        const int d = u.pn * 64 + 16 * wc + 4 * fq;
#pragma unroll
        for (int ai = 0; ai < 2; ++ai)
#pragma unroll
            for (int m = 0; m < 4; ++m) {
                const size_t r = (size_t)(row0 + ai * 128 + m * 16);
                const int su = u.pm * 4 + (u.pn >> 2), pgl = u.pn & 3, wsrc = wr * 4 + (pgl & 1) * 2 + (wc >> 1), lane = fq * 16 + fr;
                const unsigned long long q0 = __hip_atomic_load((const unsigned long long*)(up + up_slot(su, 0, ai, m, pgl >> 1, wc & 1, wsrc, lane)), __ATOMIC_RELAXED, __HIP_MEMORY_SCOPE_AGENT),
                                         q1 = __hip_atomic_load((const unsigned long long*)(up + up_slot(su, 1, ai, m, pgl >> 1, wc & 1, wsrc, lane)), __ATOMIC_RELAXED, __HIP_MEMORY_SCOPE_AGENT),
                                         q2 = __hip_atomic_load((const unsigned long long*)(up + up_slot(su, 2, ai, m, pgl >> 1, wc & 1, wsrc, lane)), __ATOMIC_RELAXED, __HIP_MEMORY_SCOPE_AGENT),
                                         q3 = __hip_atomic_load((const unsigned long long*)(up + up_slot(su, 3, ai, m, pgl >> 1, wc & 1, wsrc, lane)), __ATOMIC_RELAXED, __HIP_MEMORY_SCOPE_AGENT);
                const u32x2 w0 = {(unsigned)q0, (unsigned)(q0 >> 32)}, w1 = {(unsigned)q1, (unsigned)(q1 >> 32)}, w2 = {(unsigned)q2, (unsigned)(q2 >> 32)}, w3 = {(unsigned)q3, (unsigned)(q3 >> 32)};
                const float ri = rinv[ai][m];
                const unsigned uu[8] = {w0.x, w0.y, w1.x, w1.y, w2.x, w2.y, w3.x, w3.y};
                float o[4] = {0.f, 0.f, 0.f, 0.f};
#pragma unroll
                for (int n = 0; n < 4; ++n) {
                    const f32x4 a = acc[ai][n >> 1][m][n & 1];
                    o[0] += sigmoidf_(a[0] * ri) * bflo(uu[2 * n]); o[1] += sigmoidf_(a[1] * ri) * bfhi(uu[2 * n]);
                    o[2] += sigmoidf_(a[2] * ri) * bflo(uu[2 * n + 1]); o[3] += sigmoidf_(a[3] * ri) * bfhi(uu[2 * n + 1]);
                }
                st4bf(mg + r * DM + d, o[0], o[1], o[2], o[3]);
            }
    }
};

struct EpiResid {
    const float* xin; float* xout; bf16_t* xb; float* ssq;
    __device__ __forceinline__ void operator()(const Acc& acc, const pg8::Unit& u, int wr, int wc, int fr, int fq) const {
        const int row0 = u.pm * 256 + wr * 64 + fr;
#pragma unroll
        for (int ai = 0; ai < 2; ++ai)
#pragma unroll
            for (int m = 0; m < 4; ++m) {
                const size_t r = (size_t)(row0 + ai * 128 + m * 16);
                float part = 0.f;
#pragma unroll
                for (int bj = 0; bj < 2; ++bj)
#pragma unroll
                    for (int n = 0; n < 2; ++n) {
                        const int c = u.pn * 256 + 128 * bj + 32 * wc + 16 * n + 4 * fq;
                        f32x4 v = *(const f32x4*)(xin + r * DM + c) + acc[ai][bj][m][n];
                        *(f32x4*)(xout + r * DM + c) = v;
                        st4bf(xb + r * DM + c, v[0], v[1], v[2], v[3]);
                        part += (v[0] * v[0] + v[1] * v[1]) + (v[2] * v[2] + v[3] * v[3]);
                    }
                part = red4(part);
                if (fq == 0) ssq[r * 16 + u.pn * 4 + wc] = part;
            }
    }
};

struct EpiSwiglu {
    const float* ssq; bf16_t* act;
    __device__ __forceinline__ void operator()(const Acc& acc, const pg8::Unit& u, int wr, int wc, int fr, int fq) const {
        float rinv[2][4]; const int row0 = u.pm * 256 + wr * 64 + fr; row_rinv(ssq, row0, fq, rinv);
#pragma unroll
        for (int ai = 0; ai < 2; ++ai)
#pragma unroll
            for (int m = 0; m < 4; ++m) {
                const size_t r = (size_t)(row0 + ai * 128 + m * 16); const float ri = rinv[ai][m];
                float o[8];
#pragma unroll
                for (int bj = 0; bj < 2; ++bj)
#pragma unroll
                    for (int j = 0; j < 4; ++j) { const float a = acc[ai][bj][m][0][j] * ri, gg = acc[ai][bj][m][1][j] * ri; o[4 * bj + j] = a * sigmoidf_(a) * gg; }
                u32x4 w; w.x = cvt_pk_bf16(o[0], o[1]); w.y = cvt_pk_bf16(o[2], o[3]); w.z = cvt_pk_bf16(o[4], o[5]); w.w = cvt_pk_bf16(o[6], o[7]);
                *(u32x4*)(act + r * FFH + u.pn * 128 + 32 * wc + 8 * fq) = w;
            }
    }
};

__device__ __forceinline__ int map_col(int maptype, int rho) {
    const int t = rho >> 8, c = rho & 255;
    if (maptype == 1) return t * 256 + ((c >> 5) & 3) * 64 + ((c >> 7) & 1) * 32 + (c & 31);
    if (maptype == 2) { const int n = 2 * (c >> 7) + ((c >> 4) & 1), dl = ((c >> 5) & 3) * 16 + (c & 15); return n * 1024 + t * 64 + dl; }
    if (maptype == 3) { const int nn = (c >> 4) & 1, hh = t * 128 + ((c >> 7) & 1) * 64 + ((c >> 5) & 3) * 16 + (c & 15); return nn * FFH + hh; }
    return rho;
}
__device__ __forceinline__ int kperm128(int kp) { return (kp & ~127) + ((kp >> 2) & 1) * 64 + ((kp >> 5) & 3) * 16 + ((kp >> 3) & 3) * 4 + (kp & 3); }
__device__ __forceinline__ void cvt_item(const float* W, int K, int ldn, int nrows, bf16_t* WT, int maptype, const float* gain, LAS unsigned* scr, int item, int lane, int kperm = 0) {
    const int nblk = nrows >> 6, kb = item / nblk, nb = item - kb * nblk, k0 = 64 * kb, n0 = 64 * nb;
    const int l15 = lane & 15, kq = lane >> 4;
    const float* src = W + map_col(maptype, n0 + 4 * l15);
    f32x4 a[8], b[8];
#pragma unroll
    for (int i = 0; i < 8; ++i) { const int k = k0 + 8 * i + 2 * kq; const int ka = kperm ? kperm128(k) : k, kb2 = kperm ? kperm128(k + 1) : k + 1;
        a[i] = *(const f32x4*)(src + (size_t)ka * ldn); b[i] = *(const f32x4*)(src + (size_t)kb2 * ldn); }
#pragma unroll
    for (int i = 0; i < 8; ++i) { const int k = 8 * i + 2 * kq;
        if (gain) { const float g0 = gain[k0 + k], g1 = gain[k0 + k + 1]; a[i] = a[i] * g0; b[i] = b[i] * g1; }
#pragma unroll
        for (int q = 0; q < 4; ++q) scr[(4 * l15 + q) * 36 + (k >> 1)] = cvt_pk_bf16(a[i][q], b[i][q]); }
    asm volatile("s_waitcnt lgkmcnt(0)" ::: "memory");
    const int c = lane & 7;
#pragma unroll
    for (int j = 0; j < 8; ++j) { const int n = (lane >> 3) + 8 * j;
        *(u32x4*)(WT + (size_t)(n0 + n) * K + k0 + 8 * c) = *(const LAS u32x4*)(scr + n * 36 + 4 * c); }
    asm volatile("s_waitcnt lgkmcnt(0)" ::: "memory");
}
constexpr int CI_IN = 16 * 36, CI_G = 16 * 64, CI_B = 4 * 16, CI_O = 16 * 16, CI_FI = 16 * 88, CI_FO = 44 * 16, CI_M = 16 * 8;
constexpr int CI_TOTAL = CI_IN + CI_G + 4 * CI_B + CI_O + CI_FI + CI_FO + CI_M;
__device__ __forceinline__ void cvt_layer_item(const __attribute__((address_space(4))) Args* ap, int l, bf16_t* Wt, LAS unsigned* scr, int item, int lane) {
    int r = item, K = DM, ldn, nrows, mt = 0, kp = 0; const float* W; bf16_t* WT; const float* gain = nullptr;
    if (r < CI_IN) { W = ap->in[I_WIN] + (size_t)l * DM * INW; ldn = INW; nrows = INW; WT = Wt + WO_IN; mt = 1; gain = ap->in[I_NMIX] + (size_t)l * DM; }
    else if ((r -= CI_IN) < CI_G) { W = ap->in[I_WGATE] + (size_t)l * DM * 4096; ldn = 4096; nrows = 4096; WT = Wt + WO_G; mt = 2; gain = ap->in[I_NMIX] + (size_t)l * DM; }
    else if ((r -= CI_G) < 4 * CI_B) { const int nb = r / CI_B; r -= nb * CI_B; W = ap->in[I_WBR] + ((size_t)l * 4 + nb) * 256 * DM; K = 256; ldn = DM; nrows = DM; WT = Wt + WO_B + (size_t)nb * DM * 256; }
    else if ((r -= 4 * CI_B) < CI_O) { W = ap->in[I_WOUT] + (size_t)l * DM * DM; ldn = DM; nrows = DM; WT = Wt + WO_O; }
    else if ((r -= CI_O) < CI_FI) { W = ap->in[I_WFI] + (size_t)l * DM * 2 * FFH; ldn = 2 * FFH; nrows = 2 * FFH; WT = Wt + WO_FI; mt = 3; gain = ap->in[I_NFFN] + (size_t)l * DM; }
    else if ((r -= CI_FI) < CI_FO) { W = ap->in[I_WFO] + (size_t)l * FFH * DM; K = FFH; ldn = DM; nrows = DM; WT = Wt + WO_FO; kp = 1; }
    else { r -= CI_FO; W = ap->in[I_WMKV] + (size_t)l * DM * 512; ldn = 512; nrows = 512; WT = Wt + WO_M; mt = 1; gain = ap->in[I_NMEM] + (size_t)l * DM; }
    cvt_item(W, K, ldn, nrows, WT, mt, gain, scr, r, lane, kp);
}
__device__ __forceinline__ void row_to_bf16(const float* xrow, bf16_t* orow, float* ssq, int lane) {
    const f32x4* xr = (const f32x4*)xrow + lane; float s = 0.f;
#pragma unroll
    for (int j = 0; j < 4; ++j) { const f32x4 v = xr[64 * j]; s += (v.x * v.x + v.y * v.y) + (v.z * v.z + v.w * v.w); st4bf(orow + (lane + 64 * j) * 4, v.x, v.y, v.z, v.w); }
    s = wave_sum(s);
    if (lane < 16) ssq[lane] = (lane == 0) ? s : 0.f;
}

__device__ __forceinline__ float log2_sigmoid(float x) { return -log1pf(expf(-x)) * 1.4426950408889634f; }

__device__ __forceinline__ void kv_item(const unsigned char* ra, float* kvs, const float* rdf, const float* rdb, int item, int lane) {
    const int fr = lane & 15, fq = lane >> 4;
    const int dir = item & 1, n = (item >> 1) & 15, bh = item >> 5, h = bh & 3;
    const float lg2 = log2_sigmoid(dir ? rdb[h] : rdf[h]);
    const bf16_t* KRT = (const bf16_t*)(ra + RA_KRT); const bf16_t* VRT = (const bf16_t*)(ra + RA_VRT);
    f32x4 kv[4][4];
#pragma unroll
    for (int a = 0; a < 4; ++a)
#pragma unroll
        for (int b = 0; b < 4; ++b) kv[a][b] = (f32x4){0.f, 0.f, 0.f, 0.f};
#pragma unroll 2
    for (int ks = 0; ks < 4; ++ks) {
        const int sb = n * 128 + ks * 32 + fq * 8;
        float w[8];
#pragma unroll
        for (int i = 0; i < 8; ++i) { const int il = ks * 32 + fq * 8 + i; w[i] = exp2f(lg2 * (float)(dir ? il : 127 - il)); }
        bf16x8 kb[4];
#pragma unroll
        for (int dt = 0; dt < 4; ++dt) { float f[8]; unpack8(ld16(KRT + ((size_t)bh * 64 + dt * 16 + fr) * SEQ + sb), f);
#pragma unroll
            for (int i = 0; i < 8; ++i) f[i] *= w[i];
            kb[dt] = pack8(f); }
#pragma unroll
        for (int et = 0; et < 4; ++et) { const bf16x8 va = ld16(VRT + ((size_t)bh * 64 + et * 16 + fr) * SEQ + sb);
#pragma unroll
            for (int dt = 0; dt < 4; ++dt) kv[et][dt] = mfma16(va, kb[dt], kv[et][dt]); }
    }
    float* o = kvs + ((size_t)(dir * 32 + bh) * 16 + n) * 4096;
#pragma unroll
    for (int et = 0; et < 4; ++et)
#pragma unroll
        for (int dt = 0; dt < 4; ++dt)
#pragma unroll
            for (int j = 0; j < 4; ++j) o[(et * 16 + fq * 4 + j) * 64 + dt * 16 + fr] = kv[et][dt][j];
}

template <bool NA>
__device__ __forceinline__ void attn_item(const unsigned char* ra, const LAS float* rpb, bf16_t* brout, int item, int lane) {
    const int fr = lane & 15, fq = lane >> 4;
    int bh, qtok, r = 0, row_start = 0, kc0 = 0, qcol = 0, qwin = 0, h;
    const bf16_t *Q, *Kp, *VT;
    if (NA) { const int cb = item & 3; r = (item >> 2) & 31; bh = item >> 7; h = bh & 3;
        row_start = min(max(r - 4, 0), 24); kc0 = min(max(cb * 16 - 8, 0), 32); qcol = cb * 16 + fr; qwin = min(max(qcol - 8, 0), 48); qtok = r * 64 + cb * 16;
        Q = (const bf16_t*)(ra + RA_NQ); Kp = (const bf16_t*)(ra + RA_NK) + (size_t)bh * SEQ * 64; VT = (const bf16_t*)(ra + RA_NVT) + (size_t)bh * 64 * SEQ;
    } else { bh = item >> 7; h = bh & 3; qtok = (item & 127) * 16;
        Q = (const bf16_t*)(ra + RA_MQ); Kp = (const bf16_t*)(ra + RA_MK) + (size_t)bh * NMEM * 64; VT = (const bf16_t*)(ra + RA_MVT) + (size_t)bh * 64 * NMEM; }
    const int kslen = NA ? SEQ : NMEM;
    const bf16_t* qp = Q + ((size_t)bh * SEQ + qtok + fr) * 64 + fq * 8;
    const bf16x8 q0 = ld16(qp), q1 = ld16(qp + 32);
    const int krel = (fr >> 2) * 8 + (fr & 3);
    bf16x8 kf[8][2][2];
#pragma unroll
    for (int g = 0; g < 8; ++g) {
        const int kbase = NA ? ((row_start + g) * 64 + kc0) : g * 32;
#pragma unroll
        for (int T = 0; T < 2; ++T) { const bf16_t* kp = Kp + (size_t)(kbase + krel + 4 * T) * 64 + fq * 8; kf[g][T][0] = ld16(kp); kf[g][T][1] = ld16(kp + 32); }
    }
    f32x4 sc[8][2];
    bf16x8 vf[8][4];
    float mx = -3.0e38f;
#pragma unroll
    for (int hf = 0; hf < 2; ++hf) {
#pragma unroll
        for (int g = 4 * hf; g < 4 * hf + 4; ++g) {
#pragma unroll
            for (int T = 0; T < 2; ++T) {
                f32x4 a = mfma16(kf[g][T][0], q0, (f32x4){0.f, 0.f, 0.f, 0.f}); a = mfma16(kf[g][T][1], q1, a);
                if (NA) {
                    const LAS float* bp = rpb + (h * 15 + (row_start + g - r + 7)) * 31;
#pragma unroll
                    for (int j = 0; j < 4; ++j) { const int kc = kc0 + fq * 8 + j + 4 * T; const bool ok = (kc >= qwin) && (kc < qwin + 16);
                        const int bi = min(max(kc - qcol + 15, 0), 30);
                        const float bv = bp[bi];
                        a[j] = ok ? a[j] + bv : (-1.0e30f + bv * 0.f); }
                }
                sc[g][T] = a;
                mx = fmaxf(mx, fmaxf(fmaxf(a[0], a[1]), fmaxf(a[2], a[3])));
            }
        }
#pragma unroll
        for (int g = 4 * hf; g < 4 * hf + 4; ++g) {
            const int kbase = NA ? ((row_start + g) * 64 + kc0) : g * 32;
#pragma unroll
            for (int et = 0; et < 4; ++et) vf[g][et] = ld16(VT + (size_t)(et * 16 + fr) * kslen + kbase + fq * 8);
        }
    }
    mx = max4(mx);
    float sum = 0.f;
#pragma unroll
    for (int g = 0; g < 8; ++g)
#pragma unroll
        for (int T = 0; T < 2; ++T)
#pragma unroll
            for (int j = 0; j < 4; ++j) { const float p = __expf(sc[g][T][j] - mx); sc[g][T][j] = p; sum += p; }
    sum = red4(sum);
    f32x4 o[4];
#pragma unroll
    for (int et = 0; et < 4; ++et) o[et] = (f32x4){0.f, 0.f, 0.f, 0.f};
#pragma unroll
    for (int g = 0; g < 8; ++g) {
        float f[8] = {sc[g][0][0], sc[g][0][1], sc[g][0][2], sc[g][0][3], sc[g][1][0], sc[g][1][1], sc[g][1][2], sc[g][1][3]};
        const bf16x8 pb = pack8(f);
#pragma unroll
        for (int et = 0; et < 4; ++et) o[et] = mfma16(vf[g][et], pb, o[et]);
    }
    const float inv = 1.f / sum;
    const int b = bh >> 2;
    bf16_t* op = brout + ((size_t)b * SEQ + qtok + fr) * 256 + h * 64 + fq * 4;
#pragma unroll
    for (int et = 0; et < 4; ++et) st4bf(op + et * 16, o[et][0] * inv, o[et][1] * inv, o[et][2] * inv, o[et][3] * inv);
}

template <bool NA>
__device__ __forceinline__ void attn4_item(const unsigned char* ra, const LAS float* rpb, bf16_t* brout, int item, int lane) {
    const int fr = lane & 15, fq = lane >> 4;
    int bh, kc0 = 0, qcol = 0, qwin = 0, r0 = 0, g_lo = 0, g_hi = 8, qt0;
    const bf16_t *Q, *Kp, *VT;
    if (NA) { const int cb = item & 3; r0 = ((item >> 2) & 7) * 4; bh = item >> 5;
        kc0 = min(max(cb * 16 - 8, 0), 32); qcol = cb * 16 + fr; qwin = min(max(qcol - 8, 0), 48); qt0 = r0 * 64 + cb * 16;
        g_lo = min(max(r0 - 4, 0), 24); g_hi = min(max(r0 - 1, 0), 24) + 8;
        Q = (const bf16_t*)(ra + RA_NQ); Kp = (const bf16_t*)(ra + RA_NK) + (size_t)bh * SEQ * 64; VT = (const bf16_t*)(ra + RA_NVT) + (size_t)bh * 64 * SEQ;
    } else { bh = item >> 5; qt0 = (item & 31) * 64;
        Q = (const bf16_t*)(ra + RA_MQ); Kp = (const bf16_t*)(ra + RA_MK) + (size_t)bh * NMEM * 64; VT = (const bf16_t*)(ra + RA_MVT) + (size_t)bh * 64 * NMEM; }
    const int h = bh & 3, b = bh >> 2;
    const int kslen = NA ? SEQ : NMEM, qstride = NA ? 64 : 16;
    bf16x8 q[4][2];
#pragma unroll
    for (int i = 0; i < 4; ++i) { const bf16_t* qp = Q + ((size_t)bh * SEQ + qt0 + i * qstride + fr) * 64 + fq * 8; q[i][0] = ld16(qp); q[i][1] = ld16(qp + 32); }
    f32x4 o[4][4]; float m[4], l[4];
#pragma unroll
    for (int i = 0; i < 4; ++i) { m[i] = -3.0e38f; l[i] = 0.f;
#pragma unroll
        for (int et = 0; et < 4; ++et) o[i][et] = (f32x4){0.f, 0.f, 0.f, 0.f}; }
    const int krel = (fr >> 2) * 8 + (fr & 3);
    const bf16_t* kpl = Kp + (size_t)krel * 64 + fq * 8;
    const bf16_t* vpl = VT + (size_t)fr * kslen + fq * 8;
#define A4_LOAD(g_, kf_, vf_) do { const int kb_ = NA ? (g_) * 64 + kc0 : (g_) * 32; \
        kf_[0][0] = ld16(kpl + (size_t)kb_ * 64); kf_[0][1] = ld16(kpl + (size_t)kb_ * 64 + 32); kf_[1][0] = ld16(kpl + (size_t)(kb_ + 4) * 64); kf_[1][1] = ld16(kpl + (size_t)(kb_ + 4) * 64 + 32); \
        _Pragma("unroll") for (int et_ = 0; et_ < 4; ++et_) vf_[et_] = ld16(vpl + (size_t)et_ * 16 * kslen + kb_); } while (0)
    bf16x8 kc[2][2], vc[4], kn[2][2], vn[4];
    A4_LOAD(g_lo, kc, vc);
#pragma unroll 1
    for (int g = g_lo; g < g_hi; ++g) {
        const int gn = min(g + 1, g_hi - 1);
        A4_LOAD(gn, kn, vn);
#pragma unroll
        for (int i = 0; i < 4; ++i) {
            bool act = true;
            if (NA) { const int rsi = min(max(r0 + i - 4, 0), 24); act = (g >= rsi) && (g < rsi + 8); }
            if (act) {
                f32x4 s0 = mfma16(kc[0][0], q[i][0], (f32x4){0.f, 0.f, 0.f, 0.f}); s0 = mfma16(kc[0][1], q[i][1], s0);
                f32x4 s1 = mfma16(kc[1][0], q[i][0], (f32x4){0.f, 0.f, 0.f, 0.f}); s1 = mfma16(kc[1][1], q[i][1], s1);
                if (NA) {
                    const LAS float* bp = rpb + (h * 15 + (g - (r0 + i) + 7)) * 31;
#pragma unroll
                    for (int j = 0; j < 4; ++j) {
                        { const int kcx = kc0 + fq * 8 + j; const bool ok = (kcx >= qwin) && (kcx < qwin + 16); const float bv = bp[min(max(kcx - qcol + 15, 0), 30)];
                          s0[j] = ok ? s0[j] + bv : (-1.0e30f + bv * 0.f); }
                        { const int kcx = kc0 + fq * 8 + j + 4; const bool ok = (kcx >= qwin) && (kcx < qwin + 16); const float bv = bp[min(max(kcx - qcol + 15, 0), 30)];
                          s1[j] = ok ? s1[j] + bv : (-1.0e30f + bv * 0.f); }
                    }
                }
                float mloc = fmaxf(fmaxf(fmaxf(s0[0], s0[1]), fmaxf(s0[2], s0[3])), fmaxf(fmaxf(s1[0], s1[1]), fmaxf(s1[2], s1[3])));
                mloc = max4(mloc);
                const float mn = fmaxf(m[i], mloc), alpha = __expf(m[i] - mn); m[i] = mn;
                float p[8]; float ps = 0.f;
#pragma unroll
                for (int j = 0; j < 4; ++j) { p[j] = __expf(s0[j] - mn); p[4 + j] = __expf(s1[j] - mn); ps += p[j] + p[4 + j]; }
                l[i] = l[i] * alpha + ps;
                const bf16x8 pb = pack8(p);
#pragma unroll
                for (int et = 0; et < 4; ++et) { o[i][et] = o[i][et] * alpha; o[i][et] = mfma16(vc[et], pb, o[i][et]); }
            }
        }
#pragma unroll
        for (int T = 0; T < 2; ++T) { kc[T][0] = kn[T][0]; kc[T][1] = kn[T][1]; }
#pragma unroll
        for (int et = 0; et < 4; ++et) vc[et] = vn[et];
    }
#undef A4_LOAD
#pragma unroll
    for (int i = 0; i < 4; ++i) {
        const float inv = 1.f / red4(l[i]);
        bf16_t* op = brout + ((size_t)b * SEQ + qt0 + i * qstride + fr) * 256 + h * 64 + fq * 4;
#pragma unroll
        for (int et = 0; et < 4; ++et) st4bf(op + et * 16, o[i][et][0] * inv, o[i][et][1] * inv, o[i][et][2] * inv, o[i][et][3] * inv);
    }
}

__device__ __forceinline__ void pool_item(const unsigned char* ra, const bf16_t* poolwt  , const float* pscale, bf16_t* brout, int item, int lane) {
    const int fr = lane & 15, fq = lane >> 4;
    const int tt = item & 127, g = (item >> 7) & 3, b = item >> 9;
    const int t0 = tt * 16, t = t0 + fr, half = 1 << g;
    const int lo = max(t - half, 0), hi = min(t + half, SEQ);
    const float ic = 1.f / (float)(hi - lo);
    float wv[8];
#pragma unroll
    for (int i = 0; i < 8; ++i) { const int u = t0 - 8 + fq * 8 + i; wv[i] = ((u >= lo && u < hi) ? ic : 0.f) - ((u == t) ? 1.f : 0.f); }
    const bf16x8 band = pack8(wv);
    const int uc = min(max(t0 - 8 + fq * 8, 0), SEQ - 8);
    const bf16_t* base = (const bf16_t*)(ra + RA_PV) + ((size_t)(b * 4 + g) * 64 + fr) * SEQ + uc;
    f32x4 pl[4];
#pragma unroll
    for (int ct = 0; ct < 4; ++ct) pl[ct] = mfma16(ld16(base + (size_t)ct * 16 * SEQ), band, (f32x4){0.f, 0.f, 0.f, 0.f});
    float f0[8] = {pl[0][0], pl[0][1], pl[0][2], pl[0][3], pl[1][0], pl[1][1], pl[1][2], pl[1][3]};
    float f1[8] = {pl[2][0], pl[2][1], pl[2][2], pl[2][3], pl[3][0], pl[3][1], pl[3][2], pl[3][3]};
    const bf16x8 p0 = pack8_safe(f0), p1 = pack8_safe(f1);
    bf16_t* op = brout + ((size_t)b * SEQ + t) * 256 + g * 64 + fq * 4;
#pragma unroll
    for (int et = 0; et < 4; ++et) {
        const bf16_t* wp = poolwt + ((size_t)g * 64 + et * 16 + fr) * 64 + fq * 8;
        f32x4 o = mfma16(ld16(wp), p0, (f32x4){0.f, 0.f, 0.f, 0.f}); o = mfma16(ld16(wp + 32), p1, o);
        const f32x4 sv = *(const f32x4*)(pscale + g * 64 + et * 16 + fq * 4);
        st4bf(op + et * 16, o[0] * sv[0], o[1] * sv[1], o[2] * sv[2], o[3] * sv[3]);
    }
}

__device__ __forceinline__ void ret_item(const unsigned char* ra, const float* kvs, const float* rdf, const float* rdb, const float* rng  , bf16_t* brout,
                                         LAS unsigned char* lds, int item, int tid) {
    const int lane = tid & 63, w = __builtin_amdgcn_readfirstlane(tid >> 6), fr = lane & 15, fq = lane >> 4;
    const int n = item & 15, bh = item >> 4, h = bh & 3, b = bh >> 2;
    const float lgf = log2_sigmoid(rdf[h]), lgb = log2_sigmoid(rdb[h]);
    LAS bf16_t* SF = (LAS bf16_t*)lds; LAS bf16_t* SB = SF + 64 * 72;
    {
        const float cdF = exp2f(lgf * 128.f), cdB = exp2f(lgb * 128.f);
        const int idx = tid * 8, e = idx >> 6, d = idx & 63;
        float aF[8], aB[8];
#pragma unroll
        for (int i = 0; i < 8; ++i) { aF[i] = 0.f; aB[i] = 0.f; }
        const float* pF = kvs + ((size_t)(0 * 32 + bh) * 16) * 4096 + idx; const float* pB = kvs + ((size_t)(1 * 32 + bh) * 16) * 4096 + idx;
        f32x4 x0[15], x1[15];
#pragma unroll
        for (int j = 0; j < 15; ++j) { const float* p = (j < n) ? pF + (size_t)j * 4096 : pB + (size_t)(j + 1) * 4096; x0[j] = *(const f32x4*)p; x1[j] = *(const f32x4*)(p + 4); }
#pragma unroll
        for (int j = 0; j < 15; ++j) if (j < n) {
#pragma unroll
            for (int i = 0; i < 4; ++i) { aF[i] = cdF * aF[i] + x0[j][i]; aF[4 + i] = cdF * aF[4 + i] + x1[j][i]; } }
#pragma unroll
        for (int j = 14; j >= 0; --j) if (j >= n) {
#pragma unroll
            for (int i = 0; i < 4; ++i) { aB[i] = cdB * aB[i] + x0[j][i]; aB[4 + i] = cdB * aB[4 + i] + x1[j][i]; } }
        *(LAS bf16x8*)(SF + e * 72 + d) = pack8(aF); *(LAS bf16x8*)(SB + e * 72 + d) = pack8(aB);
    }
    const bf16_t* QR = (const bf16_t*)(ra + RA_QR) + (size_t)bh * SEQ * 64; const bf16_t* KR = (const bf16_t*)(ra + RA_KR) + (size_t)bh * SEQ * 64;
    const bf16_t* VRT = (const bf16_t*)(ra + RA_VRT) + (size_t)bh * 64 * SEQ; const bf16_t* GR = (const bf16_t*)(ra + RA_GR) + (size_t)bh * SEQ * 64;
    const int iq = w * 16 + fr, s = n * 128 + iq;
    const bf16_t* qp = QR + (size_t)s * 64 + fq * 8;
    const bf16x8 q0 = ld16(qp), q1 = ld16(qp + 32);
    const int krel = (fr >> 2) * 8 + (fr & 3);
    bf16x8 kf[4][2][2], vf[4][4];
#pragma unroll
    for (int g = 0; g < 4; ++g)
#pragma unroll
        for (int T = 0; T < 2; ++T) { const bf16_t* kp = KR + (size_t)(n * 128 + g * 32 + krel + 4 * T) * 64 + fq * 8; kf[g][T][0] = ld16(kp); kf[g][T][1] = ld16(kp + 32); }
#pragma unroll
    for (int g = 0; g < 4; ++g)
#pragma unroll
        for (int et = 0; et < 4; ++et) vf[g][et] = ld16(VRT + (size_t)(et * 16 + fr) * SEQ + n * 128 + g * 32 + fq * 8);
    __syncthreads();
    f32x4 o[4];
#pragma unroll
    for (int et = 0; et < 4; ++et) o[et] = (f32x4){0.f, 0.f, 0.f, 0.f};
#pragma unroll
    for (int g = 0; g < 4; ++g) {
        float f[8];
#pragma unroll
        for (int T = 0; T < 2; ++T) {
            f32x4 a = mfma16(kf[g][T][0], q0, (f32x4){0.f, 0.f, 0.f, 0.f}); a = mfma16(kf[g][T][1], q1, a);
#pragma unroll
            for (int j = 0; j < 4; ++j) { const int ke = g * 32 + fq * 8 + j + 4 * T; const int df = iq - ke;
                const float wgt = __builtin_amdgcn_exp2f(df >= 0 ? lgf * (float)df : lgb * (float)(-df));
                f[4 * T + j] = a[j] * wgt; }
        }
        const bf16x8 pb = pack8(f);
#pragma unroll
        for (int et = 0; et < 4; ++et) o[et] = mfma16(vf[g][et], pb, o[et]);
    }
    const float qdf = exp2f(lgf * (float)(iq + 1)), qdb = exp2f(lgb * (float)(128 - iq));
    float ssq = 0.f;
#pragma unroll
    for (int et = 0; et < 4; ++et) {
        const LAS bf16_t* sf = SF + (et * 16 + fr) * 72 + fq * 8; const LAS bf16_t* sb = SB + (et * 16 + fr) * 72 + fq * 8;
        f32x4 cf = mfma16(*(const LAS bf16x8*)sf, q0, (f32x4){0.f, 0.f, 0.f, 0.f}); cf = mfma16(*(const LAS bf16x8*)(sf + 32), q1, cf);
        f32x4 cb = mfma16(*(const LAS bf16x8*)sb, q0, (f32x4){0.f, 0.f, 0.f, 0.f}); cb = mfma16(*(const LAS bf16x8*)(sb + 32), q1, cb);
#pragma unroll
        for (int j = 0; j < 4; ++j) { o[et][j] += cf[j] * qdf + cb[j] * qdb; ssq += o[et][j] * o[et][j]; }
    }
    ssq = red4(ssq);
    const float rn = rsqrtf(ssq * (1.f / 64.f) + EPS);
    bf16_t* op = brout + ((size_t)b * SEQ + s) * 256 + h * 64 + fq * 4;
#pragma unroll
    for (int et = 0; et < 4; ++et) {
        const f32x4 gg = *(const f32x4*)(rng + h * 64 + et * 16 + fq * 4);
        const u32x2 gr = *(const u32x2*)(GR + (size_t)s * 64 + et * 16 + fq * 4);
        const float g0 = bflo(gr.x), g1 = bfhi(gr.x), g2 = bflo(gr.y), g3 = bfhi(gr.y);
        st4bf(op + et * 16, o[et][0] * rn * gg[0] * g0 * sigmoidf_(g0), o[et][1] * rn * gg[1] * g1 * sigmoidf_(g1),
              o[et][2] * rn * gg[2] * g2 * sigmoidf_(g2), o[et][3] * rn * gg[3] * g3 * sigmoidf_(g3));
    }
    __syncthreads();
}


__device__ __forceinline__ void ret2_item(const unsigned char* ra, const float* kvs, const float* rdf, const float* rdb, const float* rng  , bf16_t* brout,
                                          LAS unsigned char* lds, int pair, int tid) {
    const int lane = tid & 63, w = __builtin_amdgcn_readfirstlane(tid >> 6), fr = lane & 15, fq = lane >> 4;
    const int bh = pair >> 3, n0 = (pair & 7) * 2, h = bh & 3, b = bh >> 2;
    const float lgf = log2_sigmoid(rdf[h]), lgb = log2_sigmoid(rdb[h]);
    LAS bf16_t* SL = (LAS bf16_t*)lds;
    {
        const float cdF = exp2f(lgf * 128.f), cdB = exp2f(lgb * 128.f);
        const int idx = tid * 8, e = idx >> 6, d = idx & 63;
        const float* pF = kvs + ((size_t)(0 * 32 + bh) * 16) * 4096 + idx; const float* pB = kvs + ((size_t)(1 * 32 + bh) * 16) * 4096 + idx;
#pragma unroll 1
        for (int it = 0; it < 2; ++it) {
            const int n = n0 + it;
            float aF[8], aB[8];
#pragma unroll
            for (int i = 0; i < 8; ++i) { aF[i] = 0.f; aB[i] = 0.f; }
            f32x4 x0[15], x1[15];
#pragma unroll
            for (int j = 0; j < 15; ++j) { const float* p = (j < n) ? pF + (size_t)j * 4096 : pB + (size_t)(j + 1) * 4096; x0[j] = *(const f32x4*)p; x1[j] = *(const f32x4*)(p + 4); }
#pragma unroll
            for (int j = 0; j < 15; ++j) if (j < n) {
#pragma unroll
                for (int i = 0; i < 4; ++i) { aF[i] = cdF * aF[i] + x0[j][i]; aF[4 + i] = cdF * aF[4 + i] + x1[j][i]; } }
#pragma unroll
            for (int j = 14; j >= 0; --j) if (j >= n) {
#pragma unroll
                for (int i = 0; i < 4; ++i) { aB[i] = cdB * aB[i] + x0[j][i]; aB[4 + i] = cdB * aB[4 + i] + x1[j][i]; } }
            *(LAS bf16x8*)(SL + (it * 2 + 0) * 4608 + e * 72 + d) = pack8(aF); *(LAS bf16x8*)(SL + (it * 2 + 1) * 4608 + e * 72 + d) = pack8(aB);
        }
    }
    asm volatile("" ::: "memory");
    const int hb = w >> 2, wl = w & 3, n = n0 + hb;
    const bf16_t* QR = (const bf16_t*)(ra + RA_QR) + (size_t)bh * SEQ * 64; const bf16_t* KR = (const bf16_t*)(ra + RA_KR) + (size_t)bh * SEQ * 64;
    const bf16_t* VRT = (const bf16_t*)(ra + RA_VRT) + (size_t)bh * 64 * SEQ; const bf16_t* GR = (const bf16_t*)(ra + RA_GR) + (size_t)bh * SEQ * 64;
    const int krel = (fr >> 2) * 8 + (fr & 3);
    bf16x8 kf[4][2][2], vf[4][4];
#pragma unroll
    for (int g = 0; g < 4; ++g)
#pragma unroll
        for (int T = 0; T < 2; ++T) { const bf16_t* kp = KR + (size_t)(n * 128 + g * 32 + krel + 4 * T) * 64 + fq * 8; kf[g][T][0] = ld16(kp); kf[g][T][1] = ld16(kp + 32); }
#pragma unroll
    for (int g = 0; g < 4; ++g)
#pragma unroll
        for (int et = 0; et < 4; ++et) vf[g][et] = ld16(VRT + (size_t)(et * 16 + fr) * SEQ + n * 128 + g * 32 + fq * 8);
    __syncthreads();
    const LAS bf16_t* SF = SL + (hb * 2 + 0) * 4608; const LAS bf16_t* SB = SL + (hb * 2 + 1) * 4608;
#pragma unroll 1
    for (int t = 0; t < 2; ++t) {
        const int iq = (wl + 4 * t) * 16 + fr, s = n * 128 + iq;
        const bf16_t* qp = QR + (size_t)s * 64 + fq * 8;
        const bf16x8 qa = ld16(qp), qb = ld16(qp + 32);
        f32x4 o[4];
#pragma unroll
        for (int et = 0; et < 4; ++et) o[et] = (f32x4){0.f, 0.f, 0.f, 0.f};
#pragma unroll
        for (int g = 0; g < 4; ++g) {
            float f[8];
#pragma unroll
            for (int T = 0; T < 2; ++T) {
                f32x4 a = mfma16(kf[g][T][0], qa, (f32x4){0.f, 0.f, 0.f, 0.f}); a = mfma16(kf[g][T][1], qb, a);
#pragma unroll
                for (int j = 0; j < 4; ++j) { const int ke = g * 32 + fq * 8 + j + 4 * T; const int df = iq - ke;
                    const float wgt = __builtin_amdgcn_exp2f(df >= 0 ? lgf * (float)df : lgb * (float)(-df));
                    f[4 * T + j] = a[j] * wgt; }
            }
            const bf16x8 pb = pack8(f);
#pragma unroll
            for (int et = 0; et < 4; ++et) o[et] = mfma16(vf[g][et], pb, o[et]);
        }
        const float qdf = exp2f(lgf * (float)(iq + 1)), qdb = exp2f(lgb * (float)(128 - iq));
        float ssq = 0.f;
#pragma unroll
        for (int et = 0; et < 4; ++et) {
            const LAS bf16_t* sf = SF + (et * 16 + fr) * 72 + fq * 8; const LAS bf16_t* sb = SB + (et * 16 + fr) * 72 + fq * 8;
            f32x4 cf = mfma16(*(const LAS bf16x8*)sf, qa, (f32x4){0.f, 0.f, 0.f, 0.f}); cf = mfma16(*(const LAS bf16x8*)(sf + 32), qb, cf);
            f32x4 cb = mfma16(*(const LAS bf16x8*)sb, qa, (f32x4){0.f, 0.f, 0.f, 0.f}); cb = mfma16(*(const LAS bf16x8*)(sb + 32), qb, cb);
#pragma unroll
            for (int j = 0; j < 4; ++j) { o[et][j] += cf[j] * qdf + cb[j] * qdb; ssq += o[et][j] * o[et][j]; }
        }
        ssq = red4(ssq);
        const float rn = rsqrtf(ssq * (1.f / 64.f) + EPS);
        bf16_t* op = brout + ((size_t)b * SEQ + s) * 256 + h * 64 + fq * 4;
#pragma unroll
        for (int et = 0; et < 4; ++et) {
            const f32x4 gg = *(const f32x4*)(rng + h * 64 + et * 16 + fq * 4);
            const u32x2 gr = *(const u32x2*)(GR + (size_t)s * 64 + et * 16 + fq * 4);
            const float g0 = bflo(gr.x), g1 = bfhi(gr.x), g2 = bflo(gr.y), g3 = bfhi(gr.y);
            st4bf(op + et * 16, o[et][0] * rn * gg[0] * g0 * sigmoidf_(g0), o[et][1] * rn * gg[1] * g1 * sigmoidf_(g1),
                  o[et][2] * rn * gg[2] * g2 * sigmoidf_(g2), o[et][3] * rn * gg[3] * g3 * sigmoidf_(g3));
        }
    }
    __syncthreads();
}

#define XB_TMO      128
#define XB_XCNT(j)  (256  + 64 * (j))
#define XB_XSUB(j)  (1280 + 64 * (j))
#define XB_XGEN(j)  (2304 + 64 * (j))
#define XB_TOP      3328
#define XB_TOPGEN   3392
#define XCD_BAR_WORDS 3456
#define XB_SPIN_CAP (1u << 18)
__device__ __forceinline__ unsigned xb_ld(unsigned* p)              { return __hip_atomic_load(p, __ATOMIC_RELAXED, __HIP_MEMORY_SCOPE_AGENT); }
__device__ __forceinline__ unsigned xb_add(unsigned* p, unsigned v) { return __hip_atomic_fetch_add(p, v, __ATOMIC_RELAXED, __HIP_MEMORY_SCOPE_AGENT); }
__device__ __forceinline__ unsigned xb_xcc_id() { return (unsigned)__builtin_amdgcn_s_getreg((3 << 11) | 20) & 0xFu; }
#define XB_SPIN(cond, bar) do { unsigned _sp = 0; while (cond) { __builtin_amdgcn_s_sleep(1); \
    if ((++_sp & 255u) == 0u) { if (xb_ld(&(bar)[XB_TMO])) break; if (_sp > XB_SPIN_CAP) { atomicAdd(&(bar)[XB_TMO], 1u); break; } } } } while (0)
__device__ __forceinline__ void xcd_barrier_complete(unsigned* bar, unsigned x, unsigned& nloc, unsigned& nx) {
    const unsigned G = gridDim.x * gridDim.y * gridDim.z;
    unsigned sum, cnt, mine, sp = 0u;
    for (;;) {
        sum = 0u; cnt = 0u; mine = 0u;
#pragma unroll
        for (unsigned j = 0; j < 16; ++j) { const unsigned c = xb_ld(&bar[XB_XCNT(j)]); sum += c; cnt += (c > 0u) ? 1u : 0u; mine = (j == x) ? c : mine; }
        if (sum == G) break;
        __builtin_amdgcn_s_sleep(1);
        if ((++sp & 255u) == 0u) { if (xb_ld(&bar[XB_TMO])) break; if (sp > XB_SPIN_CAP) { atomicAdd(&bar[XB_TMO], 1u); break; } }
    }
    nloc = mine > 0u ? mine : 1u; nx = cnt > 0u ? cnt : 1u;
}
__device__ __forceinline__ void xcd_barrier(unsigned* bar, volatile LAS unsigned* st, bool leader) {
    asm volatile("s_waitcnt vmcnt(0)" ::: "memory");
    __syncthreads();
    if (leader) {
        const unsigned x = xb_xcc_id();
        __builtin_amdgcn_s_waitcnt(0);
        unsigned nloc = st[0], nx = st[1];
        if (nloc == 0u) { xcd_barrier_complete(bar, x, nloc, nx); st[0] = nloc; st[1] = nx; }
        const unsigned old = xb_add(&bar[XB_XSUB(x)], 1u);
        const unsigned gen = old / nloc;
        if (old + 1u == (gen + 1u) * nloc) {
            __builtin_amdgcn_fence(__ATOMIC_RELEASE, "agent");
            asm volatile("s_waitcnt vmcnt(0)" ::: "memory");
            const unsigned og = xb_add(&bar[XB_TOP], 1u);
            const unsigned tg = og / nx;
            if (og + 1u == (tg + 1u) * nx) xb_add(&bar[XB_TOPGEN], 1u);
            else XB_SPIN(xb_ld(&bar[XB_TOPGEN]) == tg, bar);
            __builtin_amdgcn_fence(__ATOMIC_ACQUIRE, "agent");
            xb_add(&bar[XB_XGEN(x)], 1u);
            asm volatile("s_waitcnt vmcnt(0)" ::: "memory");
        } else {
            XB_SPIN(xb_ld(&bar[XB_XGEN(x)]) == gen, bar);
            __builtin_amdgcn_fence(__ATOMIC_ACQUIRE, "agent");
            asm volatile("s_waitcnt vmcnt(0)" ::: "memory");
        }
    }
    __syncthreads();
}

__global__ void __launch_bounds__(512, 2) fwd_kernel(Args args) {
    extern __shared__ __attribute__((aligned(16))) unsigned char lds_raw[];
    LAS unsigned char* lds = (LAS unsigned char*)lds_raw;
    cg::grid_group grid = cg::this_grid();
    const int ph_lo = args.ph_lo, ph_hi = args.ph_hi;
    const int wave0 = __builtin_amdgcn_readfirstlane((int)threadIdx.x >> 6);
    if (threadIdx.x < 2) ((volatile LAS unsigned*)(lds + 131072))[threadIdx.x] = 0u;
    __syncthreads();
    bool census_posted = false;
    for (int pit = 2 * ph_lo; pit < 2 * ph_hi; ++pit) {
        const int ph = pit >> 1;
        const int l = (ph == 0) ? 0 : (ph - 1) / NPH_LAYER, k = (ph == 0) ? 0 : 1 + (ph - 1) % NPH_LAYER;
        if ((pit & 1) && !((REPM >> k) & 1)) continue;
#define PHASE_IDS int tid, G = gridDim.x, bid = blockIdx.x; asm volatile("v_mbcnt_lo_u32_b32 %0, -1, 0\n\tv_mbcnt_hi_u32_b32 %0, -1, %0" : "=v"(tid)); tid += wave0 * 64; asm volatile("" : "+v"(tid), "+s"(G), "+s"(bid)); \
        const int lane = tid & 63, wave = __builtin_amdgcn_readfirstlane(tid >> 6); const int gw = bid * 8 + wave, NGW = G * 8; (void)lane; (void)gw; (void)NGW;
        const __attribute__((address_space(4))) Args* ap = (const __attribute__((address_space(4))) Args*)__builtin_amdgcn_kernarg_segment_ptr();
        asm volatile("" : "+s"(ap));
#define AIN(i) (ap->in[i])
#define FRESH_TID(t) int t; asm volatile("v_mbcnt_lo_u32_b32 %0, -1, 0\n\tv_mbcnt_hi_u32_b32 %0, -1, %0" : "=v"(t)); t += wave0 * 64;
        unsigned char* ws = ap->ws;
        bf16_t* Wt = (bf16_t*)(ws + ((l & 1) ? WS_W1 : WS_W));
        bf16_t* XB0 = (bf16_t*)(ws + WS_XB0); bf16_t* BR = (bf16_t*)(ws + WS_BR); unsigned char* RA = ws + WS_RA; bf16_t* MEMB = (bf16_t*)(ws + WS_MEMB);
        float* SSQ0 = (float*)(ws + WS_SSQ0); float* SSQ1 = (float*)(ws + WS_SSQ1); float* SSQM = (float*)(ws + WS_SSQM); bf16_t* POOLW = (bf16_t*)(ws + WS_POOLW);
        bf16_t* XB1 = (bf16_t*)(RA + RA_XB1); bf16_t* UP = (bf16_t*)(RA + RA_UP); bf16_t* ACT = (bf16_t*)(RA + RA_ACT); bf16_t* MG = (bf16_t*)(ws + WS_MG);
        float* KVS = (float*)(RA + RA_KVS);
        float* out = ap->out;

        if (k == 0 && (PHM & 1)) { PHASE_IDS
            LAS unsigned* scr = (LAS unsigned*)(lds + wave * 9216);
            for (int it = gw; it < CI_TOTAL; it += NGW) cvt_layer_item(ap, 0, Wt, scr, it, lane);
            for (int m = gw; m < MTOK; m += NGW) row_to_bf16(AIN(I_X) + (size_t)m * DM, XB0 + (size_t)m * DM, SSQ0 + (size_t)m * 16, lane);
            for (int m = gw; m < BATCH * NMEM; m += NGW) row_to_bf16(AIN(I_MEM) + (size_t)m * DM, MEMB + (size_t)m * DM, SSQM + (size_t)m * 16, lane);
            for (int i = bid * 512 + tid; i < DEPTH * 4 * 64 * 64; i += G * 512) { const int kp = i & 63, e = (i >> 6) & 63, lg = i >> 12;
                const int c = (2 * (kp >> 5) + ((kp >> 2) & 1)) * 16 + ((kp >> 3) & 3) * 4 + (kp & 3);
                POOLW[i] = (bf16_t)(cvt_pk_bf16(AIN(I_POOLW)[(size_t)lg * 4096 + c * 64 + e], 0.f) & 0xffffu); }
            if (bid == 0 && tid < 64) ((unsigned*)(ws + WS_CTR))[tid] = 0u;
            if (bid == 0) for (int i = tid; i < XCD_BAR_WORDS; i += 512) ((unsigned*)(ws + WS_BAR))[i] = 0u;
            asm volatile("s_waitcnt vmcnt(0) lgkmcnt(0)" ::: "memory");
            __syncthreads();
        } else if (k == 1 && (PHM & 2)) { PHASE_IDS
            for (int sub = 0; sub < 2; ++sub) {
                pg8::Gemm g; pg8::StaticOrder S; EpiHead E;
                E.ap = ap; E.l = l;
                if (sub == 0) { g = pg8::Gemm{XB0, Wt + WO_IN, DM, DM, DM, 0, 0}; S.init(MTOK / 256, 9, 9, G, bid); E.memkv = 0; E.slen = SEQ; }
                else { g = pg8::Gemm{MEMB, Wt + WO_M, DM, DM, DM, 0, 0}; S.init(BATCH, 2, 2, G, (bid + G - 64 % G) % G); E.memkv = 1; E.slen = NMEM; }
                FRESH_TID(t1)
                pg8::gemm_phase<EpiHead, true, pg8::StaticOrder>(lds, g, S, E, t1);
            }
            if (l + 1 < DEPTH) {
                FRESH_TID(t3) const int lane = t3 & 63;
                LAS unsigned* scr = (LAS unsigned*)(lds + wave0 * 9216);
                bf16_t* Wn = (bf16_t*)(ws + (((l + 1) & 1) ? WS_W1 : WS_W));
                unsigned* ctr = (unsigned*)(ws + WS_CTR) + (l + 1);
                for (;;) {
                    unsigned it = 0; if (lane == 0) it = atomicAdd(ctr, 1u);
                    it = (unsigned)__builtin_amdgcn_readfirstlane((int)it);
                    if (it >= (unsigned)CI_TOTAL) break;
                    cvt_layer_item(ap, l + 1, Wn, scr, (int)it, lane);
                }
                asm volatile("s_waitcnt vmcnt(0) lgkmcnt(0)" ::: "memory");
                __syncthreads();
            }
        } else if (k == 2 && (PHM & 4)) { PHASE_IDS
            const float* rdf = AIN(I_RDF) + l * 4; const float* rdb = AIN(I_RDB) + l * 4;
            LAS float* rpb = (LAS float*)lds;
            for (int i = tid; i < 4 * 15 * 31; i += 512) rpb[i] = AIN(I_RPB)[(size_t)l * 4 * 15 * 31 + i];
            __syncthreads();
            constexpr int N_KV = 1024, N_NA = 1024, N_MA = 1024, N_PL = 4096;
            const bool mixed = (NGW == 2048);
            const int roleA = mixed ? (wave < 4) : 1, roleB = mixed ? (wave >= 4) : 1;
            const int gwa = mixed ? bid * 4 + (wave & 3) : gw, strd = mixed ? (NGW >> 1) : NGW;
            const int gwr = mixed ? gwa : (gw + NGW - (N_KV % NGW)) % NGW;
            if (roleA) for (int it = gwa; it < N_KV; it += strd) kv_item(RA, KVS, rdf, rdb, it, lane);
            if (roleB) for (int it = gwr; it < N_NA; it += strd) attn4_item<true>(RA, rpb, BR + (size_t)2 * MTOK * 256, it, lane);
            if (roleA) for (int it = gwa; it < N_MA; it += strd) attn4_item<false>(RA, rpb, BR + (size_t)3 * MTOK * 256, it, lane);
            if (NGW == 2048) {
                const int np = 2, p0 = gw * 2;
                for (int k2 = 0; k2 < np; ++k2) pool_item(RA, POOLW + (size_t)l * 4 * 4096, AIN(I_POOLS) + l * 256, BR + (size_t)1 * MTOK * 256, p0 + k2, lane);
            } else
                for (int it = gwr; it < N_PL; it += NGW) pool_item(RA, POOLW + (size_t)l * 4 * 4096, AIN(I_POOLS) + l * 256, BR + (size_t)1 * MTOK * 256, it, lane);
            __syncthreads();
        } else if (k == 3 && (PHM & 8)) { PHASE_IDS
            for (int it = bid; it < 256; it += G)
                ret2_item(RA, KVS, AIN(I_RDF) + l * 4, AIN(I_RDB) + l * 4, AIN(I_RNG) + l * 256, BR, lds, it, tid);
        } else if (k == 4 && (PHM & 16)) { PHASE_IDS
            const int vcu = (G % 8 == 0) ? (bid % 8) * (G / 8) + bid / 8 : bid;
            for (int su = vcu; su < 256; su += G) {
                const int pm = su >> 2, pd = su & 3;
                { pg8::Gemm g{BR, Wt + WO_B, 256, 256, 256, (unsigned)MTOK * 256u, (unsigned)DM * 256u}; pg8::BlockOrder S{pm, pd, 0, 0, 1, 4};
                  EpiUp E{UP}; FRESH_TID(t1)
                  pg8::gemm_phase<EpiUp, true, pg8::BlockOrder>(lds, g, S, E, t1); }
                { pg8::Gemm g{XB0, Wt + WO_G, DM, DM, DM, 0, 0}; pg8::BlockOrder S{pm, 4 * pd, 1, 0, 0, 4};
                  EpiGate E{SSQ0, UP, MG}; FRESH_TID(t2)
                  pg8::gemm_phase<EpiGate, true, pg8::BlockOrder>(lds, g, S, E, t2); }
            }
        } else if ((k == 5 || k == 7) && (PHM & 64)) { PHASE_IDS
            pg8::Gemm g; EpiResid E;
            if (k == 5) { g = pg8::Gemm{MG, Wt + WO_O, DM, DM, DM, 0, 0}; E = EpiResid{l == 0 ? AIN(I_X) : out, out, XB1, SSQ1}; }
            else { g = pg8::Gemm{ACT, Wt + WO_FO, FFH, FFH, FFH, 0, 0}; E = EpiResid{out, out, XB0, SSQ0}; }
            pg8::StaticOrder S; S.init(MTOK / 256, 4, 4, G, bid);
            pg8::gemm_phase<EpiResid, true, pg8::StaticOrder>(lds, g, S, E, tid);
        } else if (k == 6 && (PHM & 128)) { PHASE_IDS
            pg8::Gemm g{XB1, Wt + WO_FI, DM, DM, DM, 0, 0}; pg8::StaticOrder S; S.init(MTOK / 256, 22, 22, G, bid);
            EpiSwiglu E{SSQ1, ACT};
            pg8::gemm_phase<EpiSwiglu, true, pg8::StaticOrder>(lds, g, S, E, tid);
        }
        asm volatile("s_waitcnt vmcnt(0) lgkmcnt(0)" ::: "memory");
        if (pit + 1 < 2 * ph_hi) {
            int ln; asm volatile("v_mbcnt_lo_u32_b32 %0, -1, 0\n\tv_mbcnt_hi_u32_b32 %0, -1, %0" : "=v"(ln));
            const bool leader = (wave0 == 0) && (ln == 0);
            unsigned* bar = (unsigned*)(ap->ws + WS_BAR);
            if (!census_posted) {
                grid.sync();
                if (leader) (void)xb_add(&bar[XB_XCNT(xb_xcc_id())], 1u);
                census_posted = true;
            } else xcd_barrier(bar, (volatile LAS unsigned*)(lds + 131072), leader);
        }
    }
}

extern "C" void kernel_launch(void* const* d_in, const int* in_sizes, int n_in, void* d_out, int out_size, void* d_ws, size_t ws_size, hipStream_t stream) {
    static int grid = 0;
    if (grid == 0) {
        if (n_in != 22 || out_size != MTOK * DM || ws_size < WS_END) { fprintf(stderr, "kernel_launch: unexpected shapes (n_in %d, out %d, ws %zu)\n", n_in, out_size, ws_size); grid = -1; return; }
        int dev = 0, cus = 0, per_cu = 0;
        hipGetDevice(&dev);
        hipDeviceGetAttribute(&cus, hipDeviceAttributeMultiprocessorCount, dev);
        hipFuncSetAttribute((const void*)fwd_kernel, hipFuncAttributeMaxDynamicSharedMemorySize, LDS_BYTES);
        hipOccupancyMaxActiveBlocksPerMultiprocessor(&per_cu, (const void*)fwd_kernel, 512, LDS_BYTES);
        if (per_cu < 1) { fprintf(stderr, "kernel_launch: occupancy query says %d blocks per CU\n", per_cu); per_cu = 1; }
        grid = cus;
        (void)hipGetLastError();
    }
    if (grid < 0) return;
    Args a{};
    for (int i = 0; i < 22; ++i) a.in[i] = (const float*)d_in[i];
    a.out = (float*)d_out; a.ws = (unsigned char*)d_ws;
#if MK_SINGLE
    a.ph_lo = 0; a.ph_hi = NPHASES;
    void* kargs[] = {&a};
    hipError_t e = hipLaunchCooperativeKernel((const void*)fwd_kernel, dim3(grid), dim3(512), kargs, LDS_BYTES, stream);
    if (e != hipSuccess) fprintf(stderr, "cooperative launch failed: %s (grid %d)\n", hipGetErrorString(e), grid);
#else
    for (int ph = 0; ph < NPHASES; ++ph) { a.ph_lo = ph; a.ph_hi = ph + 1; hipLaunchKernelGGL(fwd_kernel, dim3(grid), dim3(512), LDS_BYTES, stream, a); }
#endif
}
```
